# Optimizing an MI355X kernel written in HIP

```python
import math
import jax, jax.numpy as jnp
from jax import lax
import numpy as np

D_MODEL = 1024
BATCH = 8
SEQ = 4096
DEPTH = 2

HEAD_DIM = 64
A_HEADS = 4
A_QK_DIM = HEAD_DIM // 2
B_HEADS = 6
B_PATTERNS = ((128, 1), (512, 4), (2048, 16))
C_HEADS = 6
C_KV_HEADS = 2
C_HALF_WINDOW = 128
C_BLOCK = 128
Q_BLOCK = 128
N_ATTN_HEADS = A_HEADS + B_HEADS + C_HEADS
FFN_HIDDEN = -(-(8 * D_MODEL) // (3 * 256)) * 256
LN_EPS = 1e-5
NEG = -1e30

A_Q = A_HEADS * 2 * A_QK_DIM
A_K = A_HEADS * 2 * A_QK_DIM
A_V = A_HEADS * HEAD_DIM
B_Q = B_HEADS * HEAD_DIM
B_K = B_HEADS * HEAD_DIM
B_V = B_HEADS * HEAD_DIM
C_Q = C_HEADS * HEAD_DIM
C_K = C_KV_HEADS * HEAD_DIM
C_V = C_KV_HEADS * HEAD_DIM
IN_SPLITS = (A_Q, A_K, A_V, B_Q, B_K, B_V, C_Q, C_K, C_V)
IN_WIDTH = A_Q + A_K + A_V + B_Q + B_K + B_V + C_Q + C_K + C_V
VALUE_SLOTS = (2, 5, 8)

kernel_name = "hybrid_diff_dilated_swa_deepnorm_encoder"


def split_points():
    pts, acc = [], 0
    for w in IN_SPLITS[:-1]:
        acc += w
        pts.append(acc)
    return pts


def alibi_slopes():
    s = (2.0 ** (-8.0 * np.arange(1, N_ATTN_HEADS + 1) / N_ATTN_HEADS)).astype(np.float32)
    s_c = jnp.asarray(s[:C_HEADS])
    s_a = jnp.asarray(s[C_HEADS:C_HEADS + A_HEADS])
    s_b = jnp.asarray(s[C_HEADS + A_HEADS:])
    return s_a, s_b, s_c


def layer_norm(x, g, b):
    xf = x.astype(jnp.float32)
    mu = jnp.mean(xf, axis=-1, keepdims=True)
    xc = xf - mu
    var = jnp.mean(xc * xc, axis=-1, keepdims=True)
    return (xc * lax.rsqrt(var + LN_EPS) * g + b).astype(x.dtype)


def rms_norm(x, g):
    xf = x.astype(jnp.float32)
    return xf * lax.rsqrt(jnp.mean(xf * xf, axis=-1, keepdims=True) + LN_EPS) * g


def banded_attention_stats(q, k, v, half, blk, slopes, dist_scale):
    bsz, g, r, L, dh = q.shape
    nb = -(-L // blk)
    lp = nb * blk
    qb = jnp.pad(q, ((0, 0), (0, 0), (0, 0), (0, lp - L), (0, 0))).reshape(bsz, g, r, nb, blk, dh)
    pad = ((0, 0), (0, 0), (blk, lp - L + blk), (0, 0))
    kp = jnp.pad(k, pad)
    vp = jnp.pad(v, pad)

    def band(a):
        return jnp.concatenate(
            [a[:, :, o:o + lp].reshape(bsz, g, nb, blk, dh) for o in (0, blk, 2 * blk)], axis=3)

    kb = band(kp)
    vb = band(vp).astype(jnp.float32)
    s = jnp.einsum('bgrnqd,bgnkd->bgrnqk', qb, kb).astype(jnp.float32) * (dh ** -0.5)
    blk_start = jnp.arange(nb)[:, None] * blk
    qpos = blk_start + jnp.arange(blk)[None]
    kpos = blk_start - blk + jnp.arange(3 * blk)[None]
    dist = jnp.abs(qpos[:, :, None] - kpos[:, None, :])
    valid = (dist <= half) & (kpos >= 0)[:, None, :] & (kpos < L)[:, None, :]
    bias = -slopes.astype(jnp.float32)[:, :, None, None, None] * (dist.astype(jnp.float32) * dist_scale)
    s = jnp.where(valid, s + bias, NEG)
    m = jnp.max(s, axis=-1)
    p = jnp.exp(s - m[..., None])
    l = jnp.sum(p, axis=-1)
    o = jnp.einsum('bgrnqk,bgnkd->bgrnqd', p, vb)
    m = m.reshape(bsz, g, r, lp)[..., :L]
    l = l.reshape(bsz, g, r, lp)[..., :L]
    o = o.reshape(bsz, g, r, lp, dh)[:, :, :, :L]
    return m, l, o


def diff_attention(q, k, v, lam, slopes, subln_g, lambda_init):
    bsz, h, T, _, dq = q.shape
    dv = v.shape[-1]
    nb = T // Q_BLOCK
    qb = q.reshape(bsz, h, nb, Q_BLOCK, 2, dq).transpose(2, 0, 1, 3, 4, 5)
    vf = v.astype(jnp.float32)
    kpos = jnp.arange(T)
    sl = slopes.astype(jnp.float32)[None, :, None, None, None]

    def block(args):
        qi, i = args
        s = jnp.einsum('bhqmd,bhkmd->bhmqk', qi, k).astype(jnp.float32) * (dq ** -0.5)
        qpos = i * Q_BLOCK + jnp.arange(Q_BLOCK)
        dist = jnp.abs(qpos[:, None] - kpos[None, :]).astype(jnp.float32)
        p = jax.nn.softmax(s - sl * dist, axis=-1)
        w = p[:, :, 0] - lam * p[:, :, 1]
        return jnp.einsum('bhqk,bhkd->bhqd', w, vf)

    o = lax.map(block, (qb, jnp.arange(nb)))
    o = o.transpose(1, 2, 0, 3, 4).reshape(bsz, h, T, dv)
    return rms_norm(o, subln_g) * (1.0 - lambda_init)


def dilated_attention(q, k, v, slopes):
    bsz, h, T, dh = q.shape
    ms, ls, os_ = [], [], []
    for window, dil in B_PATTERNS:
        half = (window // 2) // dil
        L = T // dil

        def stride(a):
            return a.reshape(bsz, h, L, dil, dh).transpose(0, 1, 3, 2, 4).reshape(bsz, h * dil, L, dh)

        m, l, o = banded_attention_stats(stride(q)[:, :, None], stride(k), stride(v), half, half,
                                         jnp.repeat(slopes, dil)[:, None], float(dil))
        ms.append(m[:, :, 0].reshape(bsz, h, dil, L).transpose(0, 1, 3, 2).reshape(bsz, h, T))
        ls.append(l[:, :, 0].reshape(bsz, h, dil, L).transpose(0, 1, 3, 2).reshape(bsz, h, T))
        os_.append(o[:, :, 0].reshape(bsz, h, dil, L, dh).transpose(0, 1, 3, 2, 4).reshape(bsz, h, T, dh))
    m_all = jnp.stack(ms)
    l_all = jnp.stack(ls)
    o_all = jnp.stack(os_)
    w = jnp.exp(m_all - jnp.max(m_all, axis=0, keepdims=True))
    return jnp.sum(w[..., None] * o_all, axis=0) / jnp.sum(w * l_all, axis=0)[..., None]


def sink_window_gqa(q, k, v, sink, slopes):
    bsz, T, _ = q.shape
    rep = C_HEADS // C_KV_HEADS
    q = q.reshape(bsz, T, C_KV_HEADS, rep, HEAD_DIM).transpose(0, 2, 3, 1, 4)
    k = k.reshape(bsz, T, C_KV_HEADS, HEAD_DIM).transpose(0, 2, 1, 3)
    v = v.reshape(bsz, T, C_KV_HEADS, HEAD_DIM).transpose(0, 2, 1, 3)
    m, l, o = banded_attention_stats(q, k, v, C_HALF_WINDOW, C_BLOCK,
                                     slopes.reshape(C_KV_HEADS, rep), 1.0)
    sk = sink.astype(jnp.float32).reshape(C_KV_HEADS, rep)[None, :, :, None]
    mx = jnp.maximum(m, sk)
    a = jnp.exp(m - mx)
    out = o * a[..., None] / (l * a + jnp.exp(sk - mx))[..., None]
    return out.transpose(0, 3, 1, 2, 4).reshape(bsz, T, C_HEADS * HEAD_DIM)


def token_mixer(h, w_in, lam, subln_g, sink, w_out, lambda_init):
    bsz, T, _ = h.shape
    proj = h @ w_in
    qa, ka, va, qb, kb, vb, qc, kc, vc = jnp.split(proj, split_points(), axis=-1)
    s_a, s_b, s_c = alibi_slopes()

    qa = qa.reshape(bsz, T, A_HEADS, 2, A_QK_DIM).transpose(0, 2, 1, 3, 4)
    ka = ka.reshape(bsz, T, A_HEADS, 2, A_QK_DIM).transpose(0, 2, 1, 3, 4)
    va = va.reshape(bsz, T, A_HEADS, HEAD_DIM).transpose(0, 2, 1, 3)
    lf = lam.astype(jnp.float32)
    lam_full = jnp.exp(jnp.sum(lf[0] * lf[1])) - jnp.exp(jnp.sum(lf[2] * lf[3])) + lambda_init
    oa = diff_attention(qa, ka, va, lam_full, s_a, subln_g.astype(jnp.float32), lambda_init)
    oa = oa.transpose(0, 2, 1, 3).reshape(bsz, T, A_V)

    def heads(a):
        return a.reshape(bsz, T, B_HEADS, HEAD_DIM).transpose(0, 2, 1, 3)
    ob = dilated_attention(heads(qb), heads(kb), heads(vb), s_b)
    ob = ob.transpose(0, 2, 1, 3).reshape(bsz, T, B_V)

    oc = sink_window_gqa(qc, kc, vc, sink, s_c)

    mixed = jnp.concatenate([oa, ob, oc], axis=-1).astype(h.dtype)
    return mixed @ w_out


def swiglu(h, w_gu, w_down):
    g, u = jnp.split(h @ w_gu, 2, axis=-1)
    return (jax.nn.silu(g) * u) @ w_down


def setup_inputs(seed: int = 0) -> dict:
    key = jax.random.key(seed)
    ks = jax.random.split(key, 13)
    beta = (8 * DEPTH) ** -0.25
    f32 = jnp.float32
    x = jax.random.normal(ks[0], (BATCH, SEQ, D_MODEL), f32)
    c = jax.random.normal(ks[1], (BATCH, D_MODEL), f32)
    w_ada = jax.random.normal(ks[2], (DEPTH, D_MODEL, 6 * D_MODEL), f32) * (0.1 * D_MODEL ** -0.5)
    b_ada = 0.02 * jax.random.normal(ks[3], (DEPTH, 6 * D_MODEL), f32)
    col_scale = np.ones((IN_WIDTH,), np.float32)
    off = 0
    for i, w in enumerate(IN_SPLITS):
        if i in VALUE_SLOTS:
            col_scale[off:off + w] = beta
        off += w
    w_in = jax.random.normal(ks[4], (DEPTH, D_MODEL, IN_WIDTH), f32) * (D_MODEL ** -0.5) * jnp.asarray(col_scale)
    lam = 0.1 * jax.random.normal(ks[5], (DEPTH, 4, A_QK_DIM), f32)
    subln_g = 1.0 + 0.02 * jax.random.normal(ks[6], (DEPTH, HEAD_DIM), f32)
    sink = 0.5 * jax.random.normal(ks[7], (DEPTH, C_HEADS), f32)
    w_out = jax.random.normal(ks[8], (DEPTH, D_MODEL, D_MODEL), f32) * (D_MODEL ** -0.5) * beta
    ln_g = 1.0 + 0.02 * jax.random.normal(ks[9], (DEPTH, 2, D_MODEL), f32)
    ln_b = 0.02 * jax.random.normal(ks[10], (DEPTH, 2, D_MODEL), f32)
    w_gu = jax.random.normal(ks[11], (DEPTH, D_MODEL, 2 * FFN_HIDDEN), f32) * (D_MODEL ** -0.5) * beta
    w_down = jax.random.normal(ks[12], (DEPTH, FFN_HIDDEN, D_MODEL), f32) * (FFN_HIDDEN ** -0.5) * beta
    return {"x": x, "c": c, "w_ada": w_ada, "b_ada": b_ada, "w_in": w_in, "lam": lam,
            "subln_g": subln_g, "sink": sink, "w_out": w_out, "ln_g": ln_g, "ln_b": ln_b,
            "w_gu": w_gu, "w_down": w_down}


def reference(x, c, w_ada, b_ada, w_in, lam, subln_g, sink, w_out, ln_g, ln_b, w_gu, w_down):
    alpha = (2 * DEPTH) ** 0.25
    for layer in range(DEPTH):
        lambda_init = 0.8 - 0.6 * math.exp(-0.3 * layer)
        mod = jax.nn.silu(c) @ w_ada[layer] + b_ada[layer]
        sh1, sc1, g1, sh2, sc2, g2 = [m[:, None, :] for m in jnp.split(mod, 6, axis=-1)]
        h = x * (1.0 + sc1) + sh1
        mix = token_mixer(h, w_in[layer], lam[layer], subln_g[layer], sink[layer], w_out[layer], lambda_init)
        x = layer_norm(alpha * x + (1.0 + g1) * mix, ln_g[layer, 0], ln_b[layer, 0])
        h = x * (1.0 + sc2) + sh2
        x = layer_norm(alpha * x + (1.0 + g2) * swiglu(h, w_gu[layer], w_down[layer]), ln_g[layer, 1], ln_b[layer, 1])
    return x
```

```cpp
#include <hip/hip_runtime.h>
#include <hip/hip_cooperative_groups.h>
#include <cstdio>
#include <cstdint>
#define MK_FUSED 1
namespace pg8 {
#define PG8_LAS __attribute__((address_space(3)))
typedef unsigned short bf16_t;
typedef short bf16x8 __attribute__((ext_vector_type(8)));
typedef float f32x4 __attribute__((ext_vector_type(4)));
typedef unsigned u32x4 __attribute__((ext_vector_type(4)));
constexpr int BM = 256, BK = 64, HALF = 128, HTB = HALF * BK * 2  , STAGE_BYTES = 8 * HTB, NXCD = 8, WGM = 8;

__host__ __device__ __forceinline__ int lds_byte(int r, int c) { const int st = (r >> 4) * 2 + (c >> 5), rr = r & 15, cc = c & 31, ob = rr * 64 + cc * 2; return st * 1024 + (ob ^ (((ob >> 9) & 1) << 5)); }
__host__ __device__ __forceinline__ void stage_rc(int b, int& R, int& C) { const int st = b / 1024, sb = b % 1024, swz = sb ^ (((sb >> 9) & 1) << 5); R = (st >> 1) * 16 + swz / 64; C = (st & 1) * 32 + (swz % 64) / 2; }
__host__ __device__ __forceinline__ int perm32(int rho) { const int n = rho >> 4, i = rho & 15; return 8 * (i >> 2) + 4 * n + (i & 3); }

struct Unit { int pm, pn; };
struct Gemm { const bf16_t* A; const bf16_t* Bt; int M, N, K; };

struct StaticOrder {
    int nM, nN, nwg, G, c;
    __host__ __device__ void init(int M, int N, int G_, int c_) { nM = M / BM; nN = N / BM; nwg = nM * nN; G = G_; c = c_; }
    __host__ __device__ bool next(int i, Unit& u) const {
        const long L = (long)i * G + c; if (L >= nwg) return false;
        int wgid = (int)L; { const int q = nwg / NXCD, r = nwg % NXCD, xcd = wgid % NXCD, off = wgid / NXCD; wgid = (xcd < r ? xcd * (q + 1) : r * (q + 1) + (xcd - r) * q) + off; }
        const int nig = WGM * nN, gid = wgid / nig, fm = gid * WGM, gsz = (nM - fm) < WGM ? (nM - fm) : WGM;
        u.pm = fm + ((wgid % nig) % gsz); u.pn = (wgid % nig) / gsz; return true;
    }
    __device__ __forceinline__ void a_ready(const Unit&) const {}
    __device__ __forceinline__ void done(const Unit&) const {}
};

__device__ __forceinline__ unsigned cvt_pk_bf16(float lo, float hi) { unsigned r; asm volatile("v_cvt_pk_bf16_f32 %0, %1, %2" : "=v"(r) : "v"(lo), "v"(hi)); return r; }
typedef float f32x2 __attribute__((ext_vector_type(2)));
__device__ __forceinline__ f32x2 gelu_pk(f32x2 v) {
    const f32x2 av = __builtin_elementwise_abs(v), d = av * 0.2316418882f + 1.0f;
    f32x2 t; t.x = __builtin_amdgcn_rcpf(d.x); t.y = __builtin_amdgcn_rcpf(d.y);
    f32x2 q = t * 0.5307027145f + (-0.7265760135f); q = q * t + 0.7107068705f; q = q * t + (-0.142248368f); q = q * t + 0.127414796f; q = q * t;
    const f32x2 s = (v * v) * (-0.72134752044f);
    f32x2 e; e.x = __builtin_amdgcn_exp2f(s.x); e.y = __builtin_amdgcn_exp2f(s.y);
    const f32x2 m = v * (q * e), r = v - m;
    f32x2 o; o.x = v.x < 0.f ? m.x : r.x; o.y = v.y < 0.f ? m.y : r.y; return o;
}

template <int ACT  > struct EpiBf16 {
    static constexpr bool PERM = true, AFTER_DRAIN = false; static_assert(ACT == 0 || ACT == 1, "EpiBf16: ACT is 0 (none) or 1 (gelu_pk)");
    bf16_t* O; int ldc; const float* bias; int split_cols; size_t split_stride; float scale0;
    __device__ __forceinline__ void operator()(const f32x4 (&acc)[2][2][4][2], const Unit& u, int wr, int wc, int fr, int fq) const {
        const int row0 = u.pm * BM + wr * 64 + fr; int colt = u.pn * BM; bf16_t* base = O;
        float sc = 1.f; if (split_cols) { const int t = colt / split_cols; base += (size_t)t * split_stride; colt -= t * split_cols; if (t == 0) sc = scale0; }
        const int col0 = colt + wc * 32 + 8 * fq, bcol0 = u.pn * BM + wc * 32 + 8 * fq;
        f32x4 bv[2][2];
#pragma unroll
        for (int bj = 0; bj < 2; ++bj)
#pragma unroll
            for (int n = 0; n < 2; ++n) bv[bj][n] = bias ? *(const f32x4*)(bias + bcol0 + bj * HALF + 4 * n) : (f32x4){0.f, 0.f, 0.f, 0.f};
#pragma unroll
        for (int ai = 0; ai < 2; ++ai)
#pragma unroll
            for (int m = 0; m < 4; ++m) { bf16_t* rowp = base + (size_t)(row0 + ai * HALF + m * 16) * ldc + col0;
#pragma unroll
                for (int bj = 0; bj < 2; ++bj) { f32x4 v0 = acc[ai][bj][m][0] + bv[bj][0], v1 = acc[ai][bj][m][1] + bv[bj][1];
                    if (ACT == 1) { f32x2 a = gelu_pk((f32x2){v0[0], v0[1]}), b = gelu_pk((f32x2){v0[2], v0[3]}), c = gelu_pk((f32x2){v1[0], v1[1]}), d = gelu_pk((f32x2){v1[2], v1[3]});
                        v0 = (f32x4){a.x, a.y, b.x, b.y}; v1 = (f32x4){c.x, c.y, d.x, d.y}; }
                    v0 = v0 * sc; v1 = v1 * sc; u32x4 w; w.x = cvt_pk_bf16(v0[0], v0[1]); w.y = cvt_pk_bf16(v0[2], v0[3]); w.z = cvt_pk_bf16(v1[0], v1[1]); w.w = cvt_pk_bf16(v1[2], v1[3]);
                    *(u32x4*)(rowp + bj * HALF) = w; } }
    }
};
struct EpiResid {
    static constexpr bool PERM = false, AFTER_DRAIN = false;
    const float* X; float* Y; const float* gate; float alpha;
    __device__ __forceinline__ void operator()(const f32x4 (&acc)[2][2][4][2], const Unit& u, int wr, int wc, int fr, int fq) const {
        const int row0 = u.pm * BM + wr * 64 + fr, col0 = u.pn * BM + wc * 32 + 4 * fq;
        const float* gp = gate + (size_t)(u.pm >> 4) * 6144 + col0;
        f32x4 gv[2][2];
#pragma unroll
        for (int bj = 0; bj < 2; ++bj)
#pragma unroll
            for (int n = 0; n < 2; ++n) gv[bj][n] = *(const f32x4*)(gp + bj * HALF + n * 16) + 1.0f;
#pragma unroll
        for (int ai = 0; ai < 2; ++ai)
#pragma unroll
            for (int m = 0; m < 4; ++m) { const size_t off = (size_t)(row0 + ai * HALF + m * 16) * 1024 + col0;
#pragma unroll
                for (int bj = 0; bj < 2; ++bj)
#pragma unroll
                    for (int n = 0; n < 2; ++n) { const f32x4 x = *(const f32x4*)(X + off + bj * HALF + n * 16);
                        *(f32x4*)(Y + off + bj * HALF + n * 16) = x * alpha + gv[bj][n] * acc[ai][bj][m][n]; } }
    }
};
struct EpiSwiGLU {
    static constexpr bool PERM = true, AFTER_DRAIN = false;
    bf16_t* O; int ldc;
    __device__ __forceinline__ void operator()(const f32x4 (&acc)[2][2][4][2], const Unit& u, int wr, int wc, int fr, int fq) const {
        const int row0 = u.pm * BM + wr * 64 + fr, col0 = u.pn * HALF + wc * 32 + 8 * fq;
#pragma unroll
        for (int ai = 0; ai < 2; ++ai)
#pragma unroll
            for (int m = 0; m < 4; ++m) { bf16_t* rowp = O + (size_t)(row0 + ai * HALF + m * 16) * ldc + col0;
                float r[8];
#pragma unroll
                for (int n = 0; n < 2; ++n)
#pragma unroll
                    for (int e = 0; e < 4; ++e) { const float g = acc[ai][0][m][n][e], uu = acc[ai][1][m][n][e];
                        r[4 * n + e] = g * __builtin_amdgcn_rcpf(1.0f + __builtin_amdgcn_exp2f(-1.4426950408889634f * g)) * uu; }
                u32x4 w; w.x = cvt_pk_bf16(r[0], r[1]); w.y = cvt_pk_bf16(r[2], r[3]); w.z = cvt_pk_bf16(r[4], r[5]); w.w = cvt_pk_bf16(r[6], r[7]);
                *(u32x4*)rowp = w; }
    }
};
template <class Epi, class Sched, bool ALIGN_EPI = false, bool SP2 = false>
__device__ __forceinline__ void gemm_phase(PG8_LAS unsigned char* lds, const Gemm g, const Sched& S, const Epi& E) {
    int tid_ = threadIdx.x; asm volatile("" : "+v"(tid_));
    const int tid = tid_, wid = __builtin_amdgcn_readfirstlane(tid >> 6), lane = tid & 63, wr = wid >> 2, wc = wid & 3, fr = lane & 15, fq = lane >> 4;
    const int K = g.K, nt = K / BK;
    unsigned voffA[2], voffB[2];
#pragma unroll
    for (int i = 0; i < 2; ++i) { int R, C; stage_rc(tid * 16 + i * 8192, R, C); const int Rb = Epi::PERM ? ((R & ~31) + perm32(R & 31)) : R;
        voffA[i] = (unsigned)(R * K + C) * 2u; voffB[i] = (unsigned)(Rb * K + C) * 2u; }
    const size_t kstep = (size_t)(BK * 2);
    const size_t hstep = (size_t)HALF * K * 2;
    const size_t tstep = 2 * hstep;
    const unsigned ldsw = (unsigned)wid * 1024u;
    const int aoff = lds_byte(wr * 64 + fr, fq * 8), boff = lds_byte(wc * 32 + fr, fq * 8);
#define PG8_SA(b, h) (((b) * 2 + (h)) * HTB)
#define PG8_SB(b, h) ((4 + (b) * 2 + (h)) * HTB)
#define PG8_STAGE(bufoff, gbase, voff) do { _Pragma("unroll") for (int _i = 0; _i < 2; ++_i) \
        __builtin_amdgcn_global_load_lds((const unsigned*)((const char*)(gbase) + (voff)[_i]), (PG8_LAS unsigned*)(lds + (bufoff) + ldsw + _i * 8192), 16, 0, 0); } while (0)
#define PG8_LDA(dst, b, h) do { _Pragma("unroll") for (int m = 0; m < 4; ++m) _Pragma("unroll") for (int k = 0; k < 2; ++k) dst[m][k] = *(const PG8_LAS bf16x8*)(lds + PG8_SA(b, h) + aoff + m * 2048 + k * 1024); } while (0)
#define PG8_LDB(dst, b, h) do { _Pragma("unroll") for (int n = 0; n < 2; ++n) _Pragma("unroll") for (int k = 0; k < 2; ++k) dst[n][k] = *(const PG8_LAS bf16x8*)(lds + PG8_SB(b, h) + boff + n * 2048 + k * 1024); } while (0)
#define PG8_MMA(ai, bj, At, Bt) do { __builtin_amdgcn_s_setprio(1); _Pragma("unroll") for (int m = 0; m < 4; ++m) _Pragma("unroll") for (int n = 0; n < 2; ++n) _Pragma("unroll") for (int k = 0; k < 2; ++k) \
        acc[ai][bj][m][n] = __builtin_amdgcn_mfma_f32_16x16x32_bf16(Bt[n][k], At[m][k], acc[ai][bj][m][n], 0, 0, 0); __builtin_amdgcn_s_setprio(0); } while (0)
#define PG8_WAIT_V(n) asm volatile("s_waitcnt vmcnt(" #n ")" ::: "memory")
#define PG8_WAIT_L(n) asm volatile("s_waitcnt lgkmcnt(" #n ")" ::: "memory")
#define PG8_BAR __builtin_amdgcn_s_barrier()
#define PG8_SCHED __builtin_amdgcn_sched_barrier(0)
    Unit cur, nxt; int ui = 0;
    if (!S.next(0, cur)) return;
    f32x4 acc[2][2][4][2];
#pragma unroll
    for (int a = 0; a < 2; ++a)
#pragma unroll
        for (int b = 0; b < 2; ++b)
#pragma unroll
            for (int m = 0; m < 4; ++m)
#pragma unroll
                for (int n = 0; n < 2; ++n) acc[a][b][m][n] = (f32x4){0.f, 0.f, 0.f, 0.f};
    bf16x8 At[4][2], B0[2][2], B1[2][2];
    const char* cA = (const char*)g.A + (size_t)cur.pm * tstep; const char* cB = (const char*)g.Bt + (size_t)cur.pn * tstep;
    S.a_ready(cur);
    if constexpr (SP2) {
        PG8_STAGE(PG8_SB(0, 0), cB, voffB); PG8_STAGE(PG8_SB(0, 1), cB + hstep, voffB); PG8_STAGE(PG8_SA(0, 0), cA, voffA); PG8_STAGE(PG8_SA(0, 1), cA + hstep, voffA);
        if (wr == 1) PG8_BAR;
        PG8_WAIT_V(2); PG8_BAR;
        PG8_STAGE(PG8_SB(1, 0), cB + kstep, voffB); PG8_STAGE(PG8_SA(1, 0), cA + kstep, voffA); PG8_STAGE(PG8_SB(1, 1), cB + hstep + kstep, voffB);
        PG8_WAIT_V(6); PG8_BAR;
    } else {
        PG8_STAGE(PG8_SB(0, 0), cB, voffB); PG8_STAGE(PG8_SA(0, 0), cA, voffA); PG8_STAGE(PG8_SB(0, 1), cB + hstep, voffB); PG8_STAGE(PG8_SA(0, 1), cA + hstep, voffA);
        if (wr == 1) PG8_BAR;
        PG8_WAIT_V(4); PG8_BAR;
        PG8_STAGE(PG8_SB(1, 0), cB + kstep, voffB); PG8_STAGE(PG8_SA(1, 0), cA + kstep, voffA); PG8_STAGE(PG8_SB(1, 1), cB + hstep + kstep, voffB);
        PG8_WAIT_V(6); PG8_BAR;
    }
    for (;;) {
        const bool has_next = S.next(ui + 1, nxt);
        const char* nA = has_next ? (const char*)g.A + (size_t)nxt.pm * tstep : cA; const char* nB = has_next ? (const char*)g.Bt + (size_t)nxt.pn * tstep : cB;
        for (int t = 0; t < nt; t += 2) {
            const bool last = (t == nt - 2);
            const char* a1 = cA + (size_t)(t + 1) * kstep;
            const char* a2 = last ? nA : cA + (size_t)(t + 2) * kstep; const char* b2 = last ? nB : cB + (size_t)(t + 2) * kstep;
            const char* a3 = a2 + kstep; const char* b3 = b2 + kstep;
            if (last && has_next) S.a_ready(nxt);
            if constexpr (SP2) {
            PG8_LDB(B0, 0, 0); PG8_LDB(B1, 0, 1); PG8_SCHED; PG8_LDA(At, 0, 0); PG8_STAGE(PG8_SA(1, 1), a1 + hstep, voffA);
            PG8_WAIT_V(8); PG8_WAIT_L(0); PG8_BAR; PG8_MMA(0, 0, At, B0); PG8_MMA(0, 1, At, B1); PG8_BAR; PG8_SCHED;
            PG8_LDA(At, 0, 1); PG8_STAGE(PG8_SB(0, 0), b2, voffB); PG8_STAGE(PG8_SB(0, 1), b2 + hstep, voffB); PG8_STAGE(PG8_SA(0, 0), a2, voffA);
            PG8_WAIT_V(8); PG8_WAIT_L(0); PG8_BAR; PG8_MMA(1, 0, At, B0); PG8_MMA(1, 1, At, B1); PG8_BAR; PG8_SCHED;
            PG8_LDB(B0, 1, 0); PG8_LDB(B1, 1, 1); PG8_SCHED; PG8_LDA(At, 1, 0); PG8_STAGE(PG8_SA(0, 1), a2 + hstep, voffA);
            PG8_WAIT_V(8); PG8_WAIT_L(0); PG8_BAR; PG8_MMA(0, 0, At, B0); PG8_MMA(0, 1, At, B1); PG8_BAR; PG8_SCHED;
            PG8_LDA(At, 1, 1); PG8_STAGE(PG8_SB(1, 0), b3, voffB); PG8_STAGE(PG8_SB(1, 1), b3 + hstep, voffB); PG8_STAGE(PG8_SA(1, 0), a3, voffA);
            PG8_WAIT_V(8); PG8_WAIT_L(0); PG8_BAR; PG8_MMA(1, 0, At, B0); PG8_MMA(1, 1, At, B1); PG8_BAR; PG8_SCHED;
            } else {
            PG8_LDB(B0, 0, 0); PG8_SCHED; PG8_LDA(At, 0, 0); PG8_STAGE(PG8_SA(1, 1), a1 + hstep, voffA);
            PG8_WAIT_L(8); PG8_BAR; PG8_WAIT_L(0); PG8_MMA(0, 0, At, B0); PG8_BAR; PG8_SCHED;
            PG8_LDB(B1, 0, 1); PG8_STAGE(PG8_SB(0, 0), b2, voffB);
            PG8_BAR; PG8_WAIT_L(0); PG8_MMA(0, 1, At, B1); PG8_BAR;
            PG8_LDA(At, 0, 1); PG8_STAGE(PG8_SA(0, 0), a2, voffA);
            PG8_BAR; PG8_WAIT_L(0); PG8_MMA(1, 0, At, B0); PG8_BAR; PG8_SCHED;
            PG8_STAGE(PG8_SB(0, 1), b2 + hstep, voffB);
            PG8_WAIT_V(6); PG8_BAR; PG8_MMA(1, 1, At, B1); PG8_BAR;
            PG8_LDB(B0, 1, 0); PG8_SCHED; PG8_LDA(At, 1, 0); PG8_STAGE(PG8_SA(0, 1), a2 + hstep, voffA);
            PG8_WAIT_L(8); PG8_BAR; PG8_WAIT_L(0); PG8_MMA(0, 0, At, B0); PG8_BAR; PG8_SCHED;
            PG8_LDB(B1, 1, 1); PG8_STAGE(PG8_SB(1, 0), b3, voffB);
            PG8_BAR; PG8_WAIT_L(0); PG8_MMA(0, 1, At, B1); PG8_BAR;
            PG8_LDA(At, 1, 1); PG8_STAGE(PG8_SA(1, 0), a3, voffA);
            PG8_BAR; PG8_WAIT_L(0); PG8_MMA(1, 0, At, B0); PG8_BAR; PG8_SCHED;
            PG8_STAGE(PG8_SB(1, 1), b3 + hstep, voffB);
            PG8_WAIT_V(6); PG8_BAR; PG8_MMA(1, 1, At, B1); PG8_BAR;
            }
        }
        if constexpr (ALIGN_EPI) { if (wr == 0) PG8_BAR; }
        if constexpr (!Epi::AFTER_DRAIN) { E(acc, cur, wr, wc, fr, fq); S.done(cur); }
        if (!has_next) break;
#pragma unroll
        for (int a = 0; a < 2; ++a)
#pragma unroll
            for (int b = 0; b < 2; ++b)
#pragma unroll
                for (int m = 0; m < 4; ++m)
#pragma unroll
                    for (int n = 0; n < 2; ++n) acc[a][b][m][n] = (f32x4){0.f, 0.f, 0.f, 0.f};
        cur = nxt; cA = nA; cB = nB; ++ui;
        if constexpr (ALIGN_EPI) { if (wr == 1) PG8_BAR; }
    }
    PG8_WAIT_V(0);
    if constexpr (!ALIGN_EPI) { if (wr == 0) PG8_BAR; }
    PG8_BAR;
    if constexpr (Epi::AFTER_DRAIN) { E.fused(acc, cur, wr, wc, fr, fq, lds, wid, lane); S.done(cur); }
#undef PG8_SA
#undef PG8_SB
#undef PG8_STAGE
#undef PG8_LDA
#undef PG8_LDB
#undef PG8_MMA
#undef PG8_WAIT_V
#undef PG8_WAIT_L
#undef PG8_BAR
#undef PG8_SCHED
}
}
namespace cg = cooperative_groups;
#define LAS __attribute__((address_space(3)))
#define DI __device__ __forceinline__
typedef unsigned short bf16;
typedef short bf16x8 __attribute__((ext_vector_type(8)));
typedef short v4i16_t __attribute__((ext_vector_type(4)));
typedef float f32x16 __attribute__((ext_vector_type(16)));
typedef float f32x4 __attribute__((ext_vector_type(4)));
typedef float f32x2_t __attribute__((ext_vector_type(2)));
typedef __bf16 bf16x2_t __attribute__((ext_vector_type(2)));
typedef unsigned u32x4 __attribute__((ext_vector_type(4)));
typedef unsigned u32x2 __attribute__((ext_vector_type(2)));

constexpr int NWAVES = 8;
constexpr int BATCH = 8, T = 4096, D = 1024, M = BATCH * T, NPROJ = 2560, FF = 2816, NGU = 2 * FF, DEPTH = 2, NMOD = 6 * D;
constexpr int QA = 0, KA = 256, VA = 512, QB = 768, KB = 1152, VB = 1536, QC = 1920, KC = 2304, VC = 2432;
constexpr int OA = 0, OB = 256, OC = 640;
constexpr float LN_EPS = 1e-5f, LOG2E = 1.4426950408889634f, NEGBIG = -1e30f;
constexpr size_t MiB = 1u << 20;
constexpr size_t WS_CTL = 0, CTL_ZERO_BYTES = 1 * MiB, WS_MOD = 1 * MiB, WS_W = 2 * MiB, W_LAYER = 24 * MiB;
constexpr size_t WO_IN = 0, WO_OUT = 5 * MiB, WO_GU = 7 * MiB, WO_DN = 18 * MiB;
constexpr size_t WS_H = 64 * MiB, WS_PROJ = 128 * MiB, WS_MIX = 288 * MiB, WS_ACT = 128 * MiB, WS_END = 352 * MiB;
constexpr int LDS_BYTES = 147456;
constexpr int N_PHASES = 2 + 7 * DEPTH;

DI unsigned cvtpk(float lo, float hi) { f32x2_t v = {lo, hi}; bf16x2_t b = __builtin_convertvector(v, bf16x2_t); return __builtin_bit_cast(unsigned, b); }
DI unsigned f2bf(float f) { unsigned u = __builtin_bit_cast(unsigned, f); return (u + 0x7fffu + ((u >> 16) & 1u)) >> 16; }
DI unsigned pk2(float lo, float hi) { return f2bf(lo) | (f2bf(hi) << 16); }
DI int crow(int r, int h) { return (r & 3) + 8 * (r >> 2) + 4 * h; }
DI float wave_sum(float v) {
#pragma unroll
    for (int o = 1; o < 64; o <<= 1) v += __shfl_xor(v, o);
    return v;
}
DI float slope_of(int idx) { return __builtin_amdgcn_exp2f(-0.5f * (float)(idx + 1)); }

struct Frame {
    LAS unsigned char* lds;
    int tid, lane, wave, G;
    const float *x, *c, *w_ada, *b_ada, *w_in, *lam, *subln_g, *sink, *w_out, *ln_g, *ln_b, *w_gu, *w_down;
    float* out; unsigned char* ws;
    float* mod; bf16 *H, *PROJ, *MIX, *ACT;
};
DI bf16* wptr(const Frame& F, int layer, size_t off) { return (bf16*)(F.ws + WS_W + (size_t)layer * W_LAYER + off); }

DI void p0_transpose_item(const float* W, int N, int K, bf16* WT, int k0, int n0, int drow0, LAS float* scr, int lane) {
#pragma unroll 8
    for (int i = 0; i < 32; ++i) { const int kk = 2 * i + (lane >> 5); scr[kk * 33 + (lane & 31)] = W[(size_t)(k0 + kk) * N + n0 + (lane & 31)]; }
    asm volatile("s_waitcnt lgkmcnt(0)" ::: "memory");
    const int c = lane & 7;
#pragma unroll
    for (int j = 0; j < 4; ++j) { const int n = (lane >> 3) + 8 * j; const LAS float* s = scr + (8 * c) * 33 + n;
        u32x4 o; o.x = pk2(s[0 * 33], s[1 * 33]); o.y = pk2(s[2 * 33], s[3 * 33]); o.z = pk2(s[4 * 33], s[5 * 33]); o.w = pk2(s[6 * 33], s[7 * 33]);
        *(u32x4*)(WT + (size_t)(drow0 + n) * K + k0 + 8 * c) = o; }
    asm volatile("s_waitcnt lgkmcnt(0)" ::: "memory");
}
DI void p0_phase(Frame& F) {
    {
        LAS float* sc = (LAS float*)F.lds;
        LAS float* red = sc + 8192;
        for (int i = F.tid; i < BATCH * D; i += NWAVES * 64) { const float v = F.c[i]; sc[i] = v / (1.0f + __expf(-v)); }
        __syncthreads();
        for (int cgp = blockIdx.x; cgp < DEPTH * (NMOD / 64); cgp += F.G) {
            const int layer = cgp / (NMOD / 64), colb = (cgp % (NMOD / 64)) * 64, col = colb + F.lane;
            const float* w = F.w_ada + (size_t)layer * D * NMOD + col;
            float acc[8];
#pragma unroll
            for (int b = 0; b < 8; ++b) acc[b] = 0.f;
            const int kb = F.wave * 128;
#pragma unroll 8
            for (int k = kb; k < kb + 128; ++k) { const float wv = w[(size_t)k * NMOD];
#pragma unroll
                for (int b = 0; b < 8; ++b) acc[b] += sc[b * D + k] * wv; }
#pragma unroll
            for (int b = 0; b < 8; ++b) red[(F.wave * 8 + b) * 64 + F.lane] = acc[b];
            __syncthreads();
            { const int b = F.wave; float s = 0.f;
#pragma unroll
              for (int w8 = 0; w8 < 8; ++w8) s += red[(w8 * 8 + b) * 64 + F.lane];
              F.mod[((size_t)layer * BATCH + b) * NMOD + col] = s + F.b_ada[(size_t)layer * NMOD + col]; }
            __syncthreads();
        }
    }
    {
        LAS float* scr = (LAS float*)(F.lds + 65536 + F.wave * 8704);
        const int gw = blockIdx.x * NWAVES + F.wave, NGW = F.G * NWAVES;
        constexpr int I_IN = (D / 64) * (NPROJ / 32), I_OUT = (D / 64) * (D / 32), I_GU = (D / 64) * (NGU / 32), I_DN = (FF / 64) * (D / 32), I_L = I_IN + I_OUT + I_GU + I_DN;
        for (int it = gw; it < DEPTH * I_L; it += NGW) {
            const int layer = it / I_L; int r = it % I_L;
            if (r < I_IN) { const int nb = NPROJ / 32, kb = r / nb, n0 = (r % nb) * 32;
                p0_transpose_item(F.w_in + (size_t)layer * D * NPROJ, NPROJ, D, wptr(F, layer, WO_IN), kb * 64, n0, n0, scr, F.lane); continue; } r -= I_IN;
            if (r < I_OUT) { const int nb = D / 32, kb = r / nb, n0 = (r % nb) * 32;
                p0_transpose_item(F.w_out + (size_t)layer * D * D, D, D, wptr(F, layer, WO_OUT), kb * 64, n0, n0, scr, F.lane); continue; } r -= I_OUT;
            if (r < I_GU) { const int nb = NGU / 32, kb = r / nb, n0 = (r % nb) * 32;
                const int isu = n0 >= FF, nn = isu ? n0 - FF : n0, drow = (nn / 128) * 256 + isu * 128 + (nn % 128);
                p0_transpose_item(F.w_gu + (size_t)layer * D * NGU, NGU, D, wptr(F, layer, WO_GU), kb * 64, n0, drow, scr, F.lane); continue; } r -= I_GU;
            { const int nb = D / 32, kb = r / nb, n0 = (r % nb) * 32;
                p0_transpose_item(F.w_down + (size_t)layer * FF * D, D, FF, wptr(F, layer, WO_DN), kb * 64, n0, n0, scr, F.lane); }
        }
    }
}

DI void row_mod_phase(Frame& F, const float* X, const float* sc, const float* sh, bf16* H) {
    const int gw = blockIdx.x * NWAVES + F.wave, NGW = F.G * NWAVES;
    for (int m = gw; m < M; m += NGW) { const int b = m >> 12;
        const f32x4* xr = (const f32x4*)(X + (size_t)m * D) + F.lane; const f32x4* sr = (const f32x4*)(sc + (size_t)b * NMOD) + F.lane; const f32x4* hr = (const f32x4*)(sh + (size_t)b * NMOD) + F.lane;
        u32x2* o8 = (u32x2*)(H + (size_t)m * D) + F.lane;
#pragma unroll
        for (int j = 0; j < 4; ++j) { const f32x4 v = xr[64 * j] * (sr[64 * j] + 1.0f) + hr[64 * j]; u32x2 w; w.x = cvtpk(v.x, v.y); w.y = cvtpk(v.z, v.w); o8[64 * j] = w; } }
}
DI void row_ln_phase(Frame& F, float* X, const float* g, const float* bb, const float* sc, const float* sh, bf16* H) {
    const int gw = blockIdx.x * NWAVES + F.wave, NGW = F.G * NWAVES;
    for (int m = gw; m < M; m += NGW) { const int b = m >> 12;
        f32x4* xr = (f32x4*)(X + (size_t)m * D) + F.lane;
        f32x4 v[4]; float s = 0.f;
#pragma unroll
        for (int j = 0; j < 4; ++j) { v[j] = xr[64 * j]; s += (v[j].x + v[j].y) + (v[j].z + v[j].w); }
        const float mean = wave_sum(s) * (1.f / D); float s2 = 0.f;
#pragma unroll
        for (int j = 0; j < 4; ++j) { v[j] = v[j] - mean; s2 += (v[j].x * v[j].x + v[j].y * v[j].y) + (v[j].z * v[j].z + v[j].w * v[j].w); }
        const float rstd = 1.f / sqrtf(wave_sum(s2) * (1.f / D) + LN_EPS);
        const f32x4* gr = (const f32x4*)g + F.lane; const f32x4* br = (const f32x4*)bb + F.lane;
#pragma unroll
        for (int j = 0; j < 4; ++j) { v[j] = v[j] * rstd * gr[64 * j] + br[64 * j]; xr[64 * j] = v[j]; }
        if (H) { const f32x4* sr = (const f32x4*)(sc + (size_t)b * NMOD) + F.lane; const f32x4* hr = (const f32x4*)(sh + (size_t)b * NMOD) + F.lane; u32x2* o8 = (u32x2*)(H + (size_t)m * D) + F.lane;
#pragma unroll
            for (int j = 0; j < 4; ++j) { const f32x4 h = v[j] * (sr[64 * j] + 1.0f) + hr[64 * j]; u32x2 w; w.x = cvtpk(h.x, h.y); w.y = cvtpk(h.z, h.w); o8[64 * j] = w; } }
    }
}

constexpr int VPITCH = 192;
constexpr int STG_BYTES = 32 * VPITCH;
constexpr int WAVE_LDS = STG_BYTES + 256;
constexpr int ACC_OFF = NWAVES * WAVE_LDS;
static_assert(ACC_OFF + 65536 + 2048 <= 131072, "attention LDS map");


template <int DQ>
DI void band_task(const bf16* Qp, const bf16* Kp, const bf16* Vp, int q0, int qstride, int nq, int k0, int kstride, int nkb, int W, float slope2, float scale2,
                  LAS unsigned char* stg, LAS float* scr, float& m_out, float& l_out, f32x16 (&o)[2], const int lane) {
    const int r32 = lane & 31, hi = lane >> 5;
    const bool qvalid = r32 < nq;
    const int qpos = q0 + r32 * qstride;
    const int qrow = qvalid ? qpos : q0;
    bf16x8 qf[DQ / 16];
#pragma unroll
    for (int ks = 0; ks < DQ / 16; ++ks) qf[ks] = *(const bf16x8*)(Qp + (size_t)qrow * NPROJ + ks * 16 + hi * 8);
    float m = NEGBIG, l = 0.f;
#pragma unroll
    for (int r = 0; r < 16; ++r) { o[0][r] = 0.f; o[1][r] = 0.f; }
    const LAS unsigned char* vbase = stg + (4 * hi + ((lane & 15) >> 2)) * VPITCH + ((lane >> 4) & 1) * 32 + (lane & 3) * 8;
    for (int nb = 0; nb < nkb; ++nb) {
        int kn = k0 + (nb * 32 + r32) * kstride; kn = kn < 0 ? 0 : (kn > T - 1 ? T - 1 : kn);
        bf16x8 kf[DQ / 16];
#pragma unroll
        for (int ks = 0; ks < DQ / 16; ++ks) kf[ks] = *(const bf16x8*)(Kp + (size_t)kn * NPROJ + ks * 16 + hi * 8);
#pragma unroll
        for (int i = 0; i < 4; ++i) { const int vr = (lane >> 3) + 8 * i; int vn = k0 + (nb * 32 + vr) * kstride; vn = vn < 0 ? 0 : (vn > T - 1 ? T - 1 : vn);
            const u32x4 v = *(const u32x4*)(Vp + (size_t)vn * NPROJ + (lane & 7) * 8);
            *(LAS u32x4*)(stg + vr * VPITCH + (lane & 7) * 16) = v; }
        asm volatile("" ::: "memory");
        f32x16 p;
#pragma unroll
        for (int r = 0; r < 16; ++r) p[r] = 0.f;
#pragma unroll
        for (int ks = 0; ks < DQ / 16; ++ks) p = __builtin_amdgcn_mfma_f32_32x32x16_bf16(kf[ks], qf[ks], p, 0, 0, 0);
        float mb = NEGBIG;
        const int kb0 = k0 + (nb * 32 + 4 * hi) * kstride;
#pragma unroll
        for (int r = 0; r < 16; ++r) { const int kp = kb0 + ((r & 3) + 8 * (r >> 2)) * kstride; int dist = qpos - kp; dist = dist < 0 ? -dist : dist;
            const bool ok = qvalid && kp >= 0 && kp < T && dist <= W;
            const float s = ok ? p[r] * scale2 - slope2 * (float)dist : NEGBIG; p[r] = s; mb = fmaxf(mb, s); }
        mb = fmaxf(mb, __shfl_xor(mb, 32));
        const float mn = fmaxf(m, mb), alpha = __builtin_amdgcn_exp2f(m - mn); m = mn;
        float ls = 0.f;
#pragma unroll
        for (int r = 0; r < 16; ++r) { const float e = p[r] > -1e29f ? __builtin_amdgcn_exp2f(p[r] - mn) : 0.f; p[r] = e; ls += e; }
        l = l * alpha + ls;
        asm volatile("" ::: "memory"); if (lane < 32) scr[r32] = alpha; asm volatile("" ::: "memory");
#pragma unroll
        for (int g = 0; g < 4; ++g) { const f32x4 a4 = *(const LAS f32x4*)(scr + 8 * g + 4 * hi);
#pragma unroll
            for (int e = 0; e < 4; ++e) { o[0][4 * g + e] *= a4[e]; o[1][4 * g + e] *= a4[e]; } }
        asm volatile("" ::: "memory");
#pragma unroll
        for (int s = 0; s < 2; ++s) {
            u32x4 pw; pw.x = cvtpk(p[8 * s], p[8 * s + 1]); pw.y = cvtpk(p[8 * s + 2], p[8 * s + 3]); pw.z = cvtpk(p[8 * s + 4], p[8 * s + 5]); pw.w = cvtpk(p[8 * s + 6], p[8 * s + 7]);
            const bf16x8 pa = __builtin_bit_cast(bf16x8, pw);
#pragma unroll
            for (int d0 = 0; d0 < 2; ++d0) {
                const v4i16_t lo = __builtin_amdgcn_ds_read_tr16_b64_v4i16((LAS v4i16_t*)(vbase + s * 16 * VPITCH + d0 * 64));
                const v4i16_t hh = __builtin_amdgcn_ds_read_tr16_b64_v4i16((LAS v4i16_t*)(vbase + s * 16 * VPITCH + 8 * VPITCH + d0 * 64));
                const bf16x8 vf = __builtin_shufflevector(lo, hh, 0, 1, 2, 3, 4, 5, 6, 7);
                o[d0] = __builtin_amdgcn_mfma_f32_32x32x16_bf16(pa, vf, o[d0], 0, 0, 0);
            }
        }
        asm volatile("" ::: "memory");
    }
    m_out = m; l_out = l;
}
DI void bcast_rows(LAS float* scr, float v, float (&out)[16], const int lane) {
    const int hi = lane >> 5;
    asm volatile("" ::: "memory"); if (lane < 32) scr[lane] = v; asm volatile("" ::: "memory");
#pragma unroll
    for (int g = 0; g < 4; ++g) { const f32x4 a4 = *(const LAS f32x4*)(scr + 8 * g + 4 * hi);
#pragma unroll
        for (int e = 0; e < 4; ++e) out[4 * g + e] = a4[e]; }
    asm volatile("" ::: "memory");
}
DI void store_o_tile(const f32x16 (&o)[2], bf16* MIXb  , int row0, int rstride, int col0, LAS unsigned char* stg, const int lane) {
    const int r32 = lane & 31, hi = lane >> 5;
    constexpr int OP = 144;
    asm volatile("" ::: "memory");
#pragma unroll
    for (int d0 = 0; d0 < 2; ++d0)
#pragma unroll
        for (int r = 0; r < 16; ++r) *(LAS unsigned short*)(stg + crow(r, hi) * OP + (d0 * 32 + r32) * 2) = (unsigned short)f2bf(o[d0][r]);
    asm volatile("" ::: "memory");
#pragma unroll
    for (int i = 0; i < 4; ++i) { const int row = (lane >> 3) + 8 * i; const u32x4 v = *(const LAS u32x4*)(stg + row * OP + (lane & 7) * 16);
        *(u32x4*)(MIXb + (size_t)(row0 + row * rstride) * D + col0 + (lane & 7) * 8) = v; }
    asm volatile("" ::: "memory");
}

DI void attnA_task(Frame& F, int layer, int b, int h, int q0, float lam_full, float omli, LAS unsigned char* stg, LAS float* scr) {
    const bf16* base = F.PROJ + (size_t)b * T * NPROJ;
    const float slope2 = slope_of(6 + h) * LOG2E, scale2 = 0.17677669529663687f * LOG2E;
    f32x16 o0[2], o1[2]; float m0, l0, m1, l1;
    band_task<32>(base + QA + h * 64, base + KA + h * 64, base + VA + h * 64, q0, 1, 32, 0, 1, T / 32, 1 << 20, slope2, scale2, stg, scr, m0, l0, o0, F.lane);
    band_task<32>(base + QA + h * 64 + 32, base + KA + h * 64 + 32, base + VA + h * 64, q0, 1, 32, 0, 1, T / 32, 1 << 20, slope2, scale2, stg, scr, m1, l1, o1, F.lane);
    l0 += __shfl_xor(l0, 32); l1 += __shfl_xor(l1, 32);
    float f0[16], f1[16];
    bcast_rows(scr, 1.0f / l0, f0, F.lane); bcast_rows(scr, lam_full / l1, f1, F.lane);
    const int lane = F.lane, r32 = lane & 31;
    const float g0 = F.subln_g[layer * 64 + r32] * omli, g1 = F.subln_g[layer * 64 + 32 + r32] * omli;
#pragma unroll
    for (int r = 0; r < 16; ++r) {
        const float a = o0[0][r] * f0[r] - o1[0][r] * f1[r], c = o0[1][r] * f0[r] - o1[1][r] * f1[r];
        float ss = a * a + c * c;
        ss += __shfl_xor(ss, 1); ss += __shfl_xor(ss, 2); ss += __shfl_xor(ss, 4); ss += __shfl_xor(ss, 8); ss += __shfl_xor(ss, 16);
        const float rs = 1.0f / sqrtf(ss * (1.0f / 64.0f) + LN_EPS);
        o0[0][r] = a * rs * g0; o0[1][r] = c * rs * g1;
    }
    store_o_tile(o0, F.MIX + (size_t)b * T * D, q0, 1, OA + h * 64, stg, F.lane);
}
DI void attnC_task(Frame& F, int layer, int b, int hq, int q0, LAS unsigned char* stg, LAS float* scr) {
    const bf16* base = F.PROJ + (size_t)b * T * NPROJ; const int kvh = hq / 3;
    const float slope2 = slope_of(hq) * LOG2E, scale2 = 0.125f * LOG2E;
    f32x16 o[2]; float m, l;
    band_task<64>(base + QC + hq * 64, base + KC + kvh * 64, base + VC + kvh * 64, q0, 1, 32, q0 - 128, 1, 9, 128, slope2, scale2, stg, scr, m, l, o, F.lane);
    l += __shfl_xor(l, 32);
    const float sk2 = F.sink[layer * 6 + hq] * LOG2E, mx = fmaxf(m, sk2), a = __builtin_amdgcn_exp2f(m - mx);
    const float f = a / (l * a + __builtin_amdgcn_exp2f(sk2 - mx));
    float fr[16]; bcast_rows(scr, f, fr, F.lane);
#pragma unroll
    for (int r = 0; r < 16; ++r) { o[0][r] *= fr[r]; o[1][r] *= fr[r]; }
    store_o_tile(o, F.MIX + (size_t)b * T * D, q0, 1, OC + hq * 64, stg, F.lane);
}
template <int PS>
DI void attnB_pass(Frame& F, const bf16* Qp, const bf16* Kp, const bf16* Vp, bf16* MIXb, int colo, int p0, float slope2, float scale2, LAS unsigned char* stg, LAS float* scr) {
    constexpr int dil = PS == 0 ? 16 : (PS == 1 ? 4 : 1), ntask = PS == 0 ? 16 : 8, nq = PS == 0 ? 16 : 32;
    LAS float* accO = (LAS float*)(F.lds + ACC_OFF); LAS float* accM = accO + 256 * 64; LAS float* accL = accM + 256;
    const int lane = F.lane, r32 = lane & 31, hi = lane >> 5;
#pragma unroll 1
    for (int t = F.wave; t < ntask; t += NWAVES) {
        int qfirst;
        if (PS == 0) qfirst = p0 + t; else if (PS == 1) qfirst = p0 + (t & 3) + 128 * (t >> 2); else qfirst = p0 + 32 * t;
        f32x16 o[2]; float m, l;
        band_task<64>(Qp, Kp, Vp, qfirst, dil, nq, qfirst - 64 * dil, dil, 5, 64 * dil, slope2, scale2, stg, scr, m, l, o, F.lane);
        l += __shfl_xor(l, 32);
        const int rowloc0 = qfirst - p0;
        const int qloc = rowloc0 + r32 * dil;
        float fo = 0.f, ft = 1.f, mn = m, ln = l;
        if (PS > 0) { const float mo = accM[qloc], lo = accL[qloc]; mn = fmaxf(mo, m); fo = __builtin_amdgcn_exp2f(mo - mn); ft = __builtin_amdgcn_exp2f(m - mn); ln = lo * fo + l * ft; }
        if (PS == 2) { const float inv = 1.0f / ln; fo *= inv; ft *= inv; }
        else if (lane < nq) { accM[qloc] = mn; accL[qloc] = ln; }
        if (PS == 0) {
#pragma unroll
            for (int r = 0; r < 8; ++r) { LAS float* ap = accO + (rowloc0 + crow(r, hi) * dil) * 64 + r32; ap[0] = o[0][r]; ap[32] = o[1][r]; }
        } else {
            float fo_r[16], ft_r[16];
            bcast_rows(scr, fo, fo_r, F.lane); bcast_rows(scr, ft, ft_r, F.lane);
#pragma unroll
            for (int r = 0; r < 16; ++r) { LAS float* ap = accO + (rowloc0 + crow(r, hi) * dil) * 64 + r32;
                const float a0 = ap[0] * fo_r[r] + o[0][r] * ft_r[r], a1 = ap[32] * fo_r[r] + o[1][r] * ft_r[r];
                if (PS == 1) { ap[0] = a0; ap[32] = a1; } else { o[0][r] = a0; o[1][r] = a1; } }
            if (PS == 2) store_o_tile(o, MIXb, qfirst, 1, colo, stg, F.lane);
        }
    }
}
DI void attnB_unit(Frame& F, int b, int hb, int p0, LAS unsigned char* stg, LAS float* scr) {
    const bf16* base = F.PROJ + (size_t)b * T * NPROJ;
    const bf16 *Qp = base + QB + hb * 64, *Kp = base + KB + hb * 64, *Vp = base + VB + hb * 64;
    bf16* MIXb = F.MIX + (size_t)b * T * D;
    const float slope2 = slope_of(10 + hb) * LOG2E, scale2 = 0.125f * LOG2E;
    __syncthreads();
    attnB_pass<0>(F, Qp, Kp, Vp, MIXb, OB + hb * 64, p0, slope2, scale2, stg, scr);
    __syncthreads();
    attnB_pass<1>(F, Qp, Kp, Vp, MIXb, OB + hb * 64, p0, slope2, scale2, stg, scr);
    __syncthreads();
    attnB_pass<2>(F, Qp, Kp, Vp, MIXb, OB + hb * 64, p0, slope2, scale2, stg, scr);
}
DI void attn_phase(Frame& F, int layer) {
    LAS unsigned char* stg = F.lds + F.wave * WAVE_LDS; LAS float* scr = (LAS float*)(stg + STG_BYTES);
    const float* lam = F.lam + layer * 128;
    float d1 = F.lane < 32 ? lam[F.lane] * lam[32 + F.lane] : 0.f, d2 = F.lane < 32 ? lam[64 + F.lane] * lam[96 + F.lane] : 0.f;
    d1 = wave_sum(d1); d2 = wave_sum(d2);
    const float lambda_init = 0.8f - 0.6f * __expf(-0.3f * (float)layer);
    const float lam_full = __expf(d1) - __expf(d2) + lambda_init, omli = 1.0f - lambda_init;
    constexpr int NU_A = BATCH * 4 * (T / 256), NU_C = BATCH * (T / 256), NU_B = BATCH * 6 * (T / 256);
    for (int u = blockIdx.x; u < NU_A + NU_C + NU_B; u += F.G) {
#ifndef ATTSEL
#define ATTSEL 7
#endif
        if (u < NU_A) { if (ATTSEL & 1) { const int b = u / 64, h = (u / 16) & 3, qb = u & 15; attnA_task(F, layer, b, h, qb * 256 + F.wave * 32, lam_full, omli, stg, scr); } }
        else if (u < NU_A + NU_C) { if (ATTSEL & 2) { const int uc = u - NU_A, b = uc / 16, qb = uc & 15;
#pragma unroll 1
            for (int hq = 0; hq < 6; ++hq) attnC_task(F, layer, b, hq, qb * 256 + F.wave * 32, stg, scr); } }
        else if (ATTSEL & 4) { const int ub = u - NU_A - NU_C, b = ub / 96, hb = (ub / 16) % 6, pb = ub & 15; attnB_unit(F, b, hb, pb * 256, stg, scr); }
    }
}

struct Args { const float* in[13]; float* out; unsigned char* ws; int ph_lo, ph_hi; };
__global__ void __launch_bounds__(NWAVES * 64, 2) fwd(Args args) {
    extern __shared__ __attribute__((aligned(16))) unsigned char lds[];
    Frame F;
    F.lds = (LAS unsigned char*)lds;
    F.tid = threadIdx.x; F.lane = F.tid & 63; F.wave = __builtin_amdgcn_readfirstlane(F.tid >> 6); F.G = gridDim.x;
    F.x = args.in[0]; F.c = args.in[1]; F.w_ada = args.in[2]; F.b_ada = args.in[3]; F.w_in = args.in[4]; F.lam = args.in[5]; F.subln_g = args.in[6];
    F.sink = args.in[7]; F.w_out = args.in[8]; F.ln_g = args.in[9]; F.ln_b = args.in[10]; F.w_gu = args.in[11]; F.w_down = args.in[12];
    F.out = args.out; F.ws = args.ws;
    F.mod = (float*)(args.ws + WS_MOD); F.H = (bf16*)(args.ws + WS_H); F.PROJ = (bf16*)(args.ws + WS_PROJ); F.MIX = (bf16*)(args.ws + WS_MIX); F.ACT = (bf16*)(args.ws + WS_ACT);
    cg::grid_group grid = cg::this_grid();
    const int lo = args.ph_lo, hi = args.ph_hi;
    const float alpha = 1.4142135623730951f;
#ifndef PHMASK
#define PHMASK 0x1ff
#endif
#define IN(k) (lo <= (k) && (k) < hi)
#define INM(bit, k) (((PHMASK >> (bit)) & 1) && IN(k))
#define RELANE() do { int t_ = threadIdx.x; asm volatile("" : "+v"(t_)); F.tid = t_; F.lane = t_ & 63; } while (0)
#define SEAM(k) do { if (IN(k) && IN((k) + 1)) grid.sync(); } while (0)
    if (INM(0, 0)) { RELANE(); p0_phase(F); } SEAM(0);
    if (INM(1, 1)) { RELANE(); row_mod_phase(F, F.x, F.mod + 1 * D, F.mod + 0 * D, F.H); } SEAM(1);
#pragma unroll 1
    for (int layer = 0; layer < DEPTH; ++layer) {
        const int pb = 2 + 7 * layer;
        const float* modl = F.mod + (size_t)layer * BATCH * NMOD;
        if (INM(2, pb + 0)) {
            pg8::Gemm g{F.H, wptr(F, layer, WO_IN), M, NPROJ, D}; pg8::StaticOrder S; S.init(M, NPROJ, F.G, (int)blockIdx.x);
            pg8::EpiBf16<0> E{F.PROJ, NPROJ, nullptr, 0, 0, 1.f};
            pg8::gemm_phase<pg8::EpiBf16<0>, pg8::StaticOrder, true, true>(F.lds, g, S, E);
        } SEAM(pb + 0);
        if (INM(3, pb + 1)) { RELANE(); attn_phase(F, layer); } SEAM(pb + 1);
        if (INM(4, pb + 2)) {
            pg8::Gemm g{F.MIX, wptr(F, layer, WO_OUT), M, D, D}; pg8::StaticOrder S; S.init(M, D, F.G, (int)blockIdx.x);
            pg8::EpiResid E{layer == 0 ? F.x : F.out, F.out, modl + 2 * D, alpha};
            pg8::gemm_phase<pg8::EpiResid, pg8::StaticOrder, true, true>(F.lds, g, S, E);
        } SEAM(pb + 2);
        if (INM(5, pb + 3)) { RELANE(); row_ln_phase(F, F.out, F.ln_g + (size_t)(layer * 2 + 0) * D, F.ln_b + (size_t)(layer * 2 + 0) * D, modl + 4 * D, modl + 3 * D, F.H); } SEAM(pb + 3);
        if (INM(6, pb + 4)) {
            pg8::Gemm g{F.H, wptr(F, layer, WO_GU), M, NGU, D}; pg8::StaticOrder S; S.init(M, NGU, F.G, (int)blockIdx.x);
            pg8::EpiSwiGLU E{F.ACT, FF};
            pg8::gemm_phase<pg8::EpiSwiGLU, pg8::StaticOrder, true, true>(F.lds, g, S, E);
        } SEAM(pb + 4);
        if (INM(7, pb + 5)) {
            pg8::Gemm g{F.ACT, wptr(F, layer, WO_DN), M, D, FF}; pg8::StaticOrder S; S.init(M, D, F.G, (int)blockIdx.x);
            pg8::EpiResid E{F.out, F.out, modl + 5 * D, alpha};
            pg8::gemm_phase<pg8::EpiResid, pg8::StaticOrder, true, true>(F.lds, g, S, E);
        } SEAM(pb + 5);
        if (INM(8, pb + 6)) { const bool last = layer == DEPTH - 1; const float* modn = modl + (size_t)BATCH * NMOD;
            RELANE(); row_ln_phase(F, F.out, F.ln_g + (size_t)(layer * 2 + 1) * D, F.ln_b + (size_t)(layer * 2 + 1) * D, modn + 1 * D, modn + 0 * D, last ? (bf16*)nullptr : F.H); }
        SEAM(pb + 6);
    }
#undef IN
#undef SEAM
}

#ifndef MK_FUSED
#define MK_FUSED 0
#endif
extern "C" void kernel_launch(void* const* d_in, const int* in_sizes, int n_in, void* d_out, int out_size, void* d_ws, size_t ws_size, hipStream_t stream) {
    static int grid = 0;
    if (grid == 0) {
        if (n_in != 13 || in_sizes[0] != M * D || out_size != M * D || ws_size < WS_END) { fprintf(stderr, "kernel_launch: unexpected shapes (n_in %d, in0 %d, out %d, ws %zu)\n", n_in, n_in > 0 ? in_sizes[0] : -1, out_size, ws_size); grid = -1; return; }
        int dev = 0, cus = 0, per_cu = 0;
        if (hipGetDevice(&dev) != hipSuccess || hipDeviceGetAttribute(&cus, hipDeviceAttributeMultiprocessorCount, dev) != hipSuccess) { grid = -1; return; }
        if (hipFuncSetAttribute((const void*)fwd, hipFuncAttributeMaxDynamicSharedMemorySize, LDS_BYTES) != hipSuccess) { fprintf(stderr, "kernel_launch: hipFuncSetAttribute failed\n"); grid = -1; return; }
        if (hipOccupancyMaxActiveBlocksPerMultiprocessor(&per_cu, (const void*)fwd, NWAVES * 64, LDS_BYTES) != hipSuccess || per_cu < 1) { fprintf(stderr, "kernel_launch: occupancy query says %d blocks per CU\n", per_cu); per_cu = 1; }
        (void)hipGetLastError();
        grid = cus;
    }
    if (grid < 0) return;
    Args a{};
    for (int i = 0; i < 13; ++i) a.in[i] = (const float*)d_in[i];
    a.out = (float*)d_out; a.ws = (unsigned char*)d_ws;
#if MK_FUSED
    a.ph_lo = 0; a.ph_hi = N_PHASES;
    void* kargs[] = {&a};
    hipError_t e = hipLaunchCooperativeKernel((const void*)fwd, dim3(grid), dim3(NWAVES * 64), kargs, LDS_BYTES, stream);
    if (e != hipSuccess) fprintf(stderr, "kernel_launch: cooperative launch failed: %s (grid %d)\n", hipGetErrorString(e), grid);
#else
    for (int p = 0; p < N_PHASES; ++p) { a.ph_lo = p; a.ph_hi = p + 1; hipLaunchKernelGGL(fwd, dim3(grid), dim3(NWAVES * 64), LDS_BYTES, stream, a); }
#endif
}
```

```cpp
#include <hip/hip_runtime.h>
#include <hip/hip_cooperative_groups.h>
#include <cstdio>
#include <cstdint>
#define MK_FUSED 1
namespace pg8 {
#define PG8_LAS __attribute__((address_space(3)))
typedef unsigned short bf16_t;
typedef short bf16x8 __attribute__((ext_vector_type(8)));
typedef float f32x4 __attribute__((ext_vector_type(4)));
typedef unsigned u32x4 __attribute__((ext_vector_type(4)));
constexpr int BM = 256, BK = 64, HALF = 128, HTB = HALF * BK * 2  , STAGE_BYTES = 8 * HTB, NXCD = 8, WGM = 8;

__host__ __device__ __forceinline__ int lds_byte(int r, int c) { const int st = (r >> 4) * 2 + (c >> 5), rr = r & 15, cc = c & 31, ob = rr * 64 + cc * 2; return st * 1024 + (ob ^ (((ob >> 9) & 1) << 5)); }
__host__ __device__ __forceinline__ void stage_rc(int b, int& R, int& C) { const int st = b / 1024, sb = b % 1024, swz = sb ^ (((sb >> 9) & 1) << 5); R = (st >> 1) * 16 + swz / 64; C = (st & 1) * 32 + (swz % 64) / 2; }
__host__ __device__ __forceinline__ int perm32(int rho) { const int n = rho >> 4, i = rho & 15; return 8 * (i >> 2) + 4 * n + (i & 3); }

struct Unit { int pm, pn; };
struct Gemm { const bf16_t* A; const bf16_t* Bt; int M, N, K; };

struct StaticOrder {
    int nM, nN, nwg, G, c;
    __host__ __device__ void init(int M, int N, int G_, int c_) { nM = M / BM; nN = N / BM; nwg = nM * nN; G = G_; c = c_; }
    __host__ __device__ bool next(int i, Unit& u) const {
        const long L = (long)i * G + c; if (L >= nwg) return false;
        int wgid = (int)L; { const int q = nwg / NXCD, r = nwg % NXCD, xcd = wgid % NXCD, off = wgid / NXCD; wgid = (xcd < r ? xcd * (q + 1) : r * (q + 1) + (xcd - r) * q) + off; }
        const int nig = WGM * nN, gid = wgid / nig, fm = gid * WGM, gsz = (nM - fm) < WGM ? (nM - fm) : WGM;
        u.pm = fm + ((wgid % nig) % gsz); u.pn = (wgid % nig) / gsz; return true;
    }
    __device__ __forceinline__ void a_ready(const Unit&) const {}
    __device__ __forceinline__ void done(const Unit&) const {}
};

__device__ __forceinline__ unsigned cvt_pk_bf16(float lo, float hi) { unsigned r; asm volatile("v_cvt_pk_bf16_f32 %0, %1, %2" : "=v"(r) : "v"(lo), "v"(hi)); return r; }
typedef float f32x2 __attribute__((ext_vector_type(2)));
__device__ __forceinline__ f32x2 gelu_pk(f32x2 v) {
    const f32x2 av = __builtin_elementwise_abs(v), d = av * 0.2316418882f + 1.0f;
    f32x2 t; t.x = __builtin_amdgcn_rcpf(d.x); t.y = __builtin_amdgcn_rcpf(d.y);
    f32x2 q = t * 0.5307027145f + (-0.7265760135f); q = q * t + 0.7107068705f; q = q * t + (-0.142248368f); q = q * t + 0.127414796f; q = q * t;
    const f32x2 s = (v * v) * (-0.72134752044f);
    f32x2 e; e.x = __builtin_amdgcn_exp2f(s.x); e.y = __builtin_amdgcn_exp2f(s.y);
    const f32x2 m = v * (q * e), r = v - m;
    f32x2 o; o.x = v.x < 0.f ? m.x : r.x; o.y = v.y < 0.f ? m.y : r.y; return o;
}

template <int ACT  > struct EpiBf16 {
    static constexpr bool PERM = true, AFTER_DRAIN = false; static_assert(ACT == 0 || ACT == 1, "EpiBf16: ACT is 0 (none) or 1 (gelu_pk)");
    bf16_t* O; int ldc; const float* bias; int split_cols; size_t split_stride; float scale0;
    __device__ __forceinline__ void operator()(const f32x4 (&acc)[2][2][4][2], const Unit& u, int wr, int wc, int fr, int fq) const {
        const int row0 = u.pm * BM + wr * 64 + fr; int colt = u.pn * BM; bf16_t* base = O;
        float sc = 1.f; if (split_cols) { const int t = colt / split_cols; base += (size_t)t * split_stride; colt -= t * split_cols; if (t == 0) sc = scale0; }
        const int col0 = colt + wc * 32 + 8 * fq, bcol0 = u.pn * BM + wc * 32 + 8 * fq;
        f32x4 bv[2][2];
#pragma unroll
        for (int bj = 0; bj < 2; ++bj)
#pragma unroll
            for (int n = 0; n < 2; ++n) bv[bj][n] = bias ? *(const f32x4*)(bias + bcol0 + bj * HALF + 4 * n) : (f32x4){0.f, 0.f, 0.f, 0.f};
#pragma unroll
        for (int ai = 0; ai < 2; ++ai)
#pragma unroll
            for (int m = 0; m < 4; ++m) { bf16_t* rowp = base + (size_t)(row0 + ai * HALF + m * 16) * ldc + col0;
#pragma unroll
                for (int bj = 0; bj < 2; ++bj) { f32x4 v0 = acc[ai][bj][m][0] + bv[bj][0], v1 = acc[ai][bj][m][1] + bv[bj][1];
                    if (ACT == 1) { f32x2 a = gelu_pk((f32x2){v0[0], v0[1]}), b = gelu_pk((f32x2){v0[2], v0[3]}), c = gelu_pk((f32x2){v1[0], v1[1]}), d = gelu_pk((f32x2){v1[2], v1[3]});
                        v0 = (f32x4){a.x, a.y, b.x, b.y}; v1 = (f32x4){c.x, c.y, d.x, d.y}; }
                    v0 = v0 * sc; v1 = v1 * sc; u32x4 w; w.x = cvt_pk_bf16(v0[0], v0[1]); w.y = cvt_pk_bf16(v0[2], v0[3]); w.z = cvt_pk_bf16(v1[0], v1[1]); w.w = cvt_pk_bf16(v1[2], v1[3]);
                    *(u32x4*)(rowp + bj * HALF) = w; } }
    }
};
struct EpiResid {
    static constexpr bool PERM = false, AFTER_DRAIN = false;
    const float* X; float* Y; const float* gate; float alpha;
    __device__ __forceinline__ void operator()(const f32x4 (&acc)[2][2][4][2], const Unit& u, int wr, int wc, int fr, int fq) const {
        const int row0 = u.pm * BM + wr * 64 + fr, col0 = u.pn * BM + wc * 32 + 4 * fq;
        const float* gp = gate + (size_t)(u.pm >> 4) * 6144 + col0;
        f32x4 gv[2][2];
#pragma unroll
        for (int bj = 0; bj < 2; ++bj)
#pragma unroll
            for (int n = 0; n < 2; ++n) gv[bj][n] = *(const f32x4*)(gp + bj * HALF + n * 16) + 1.0f;
#pragma unroll
        for (int ai = 0; ai < 2; ++ai)
#pragma unroll
            for (int m = 0; m < 4; ++m) { const size_t off = (size_t)(row0 + ai * HALF + m * 16) * 1024 + col0;
#pragma unroll
                for (int bj = 0; bj < 2; ++bj)
#pragma unroll
                    for (int n = 0; n < 2; ++n) { const f32x4 x = *(const f32x4*)(X + off + bj * HALF + n * 16);
                        *(f32x4*)(Y + off + bj * HALF + n * 16) = x * alpha + gv[bj][n] * acc[ai][bj][m][n]; } }
    }
};
struct EpiSwiGLU {
    static constexpr bool PERM = true, AFTER_DRAIN = false;
    bf16_t* O; int ldc;
    __device__ __forceinline__ void operator()(const f32x4 (&acc)[2][2][4][2], const Unit& u, int wr, int wc, int fr, int fq) const {
        const int row0 = u.pm * BM + wr * 64 + fr, col0 = u.pn * HALF + wc * 32 + 8 * fq;
#pragma unroll
        for (int ai = 0; ai < 2; ++ai)
#pragma unroll
            for (int m = 0; m < 4; ++m) { bf16_t* rowp = O + (size_t)(row0 + ai * HALF + m * 16) * ldc + col0;
                float r[8];
#pragma unroll
                for (int n = 0; n < 2; ++n)
#pragma unroll
                    for (int e = 0; e < 4; ++e) { const float g = acc[ai][0][m][n][e], uu = acc[ai][1][m][n][e];
                        r[4 * n + e] = g * __builtin_amdgcn_rcpf(1.0f + __builtin_amdgcn_exp2f(-1.4426950408889634f * g)) * uu; }
                u32x4 w; w.x = cvt_pk_bf16(r[0], r[1]); w.y = cvt_pk_bf16(r[2], r[3]); w.z = cvt_pk_bf16(r[4], r[5]); w.w = cvt_pk_bf16(r[6], r[7]);
                *(u32x4*)rowp = w; }
    }
};

struct EpiProj {
    static constexpr bool PERM = true, AFTER_DRAIN = false;
    bf16_t* O; int ldc;
    __device__ __forceinline__ void operator()(const f32x4 (&acc)[2][2][4][2], const Unit& u, int wr, int wc, int fr, int fq) const {
        const int row0 = u.pm * BM + wr * 64 + fr, col0 = u.pn * BM + wc * 32 + 8 * fq;
        const float SA = 0.17677669529663687f * 1.4426950408889634f, SB = 0.125f * 1.4426950408889634f;
        float scj[2];
#pragma unroll
        for (int bj = 0; bj < 2; ++bj) { const int c = u.pn * 2 + bj;
            scj[bj] = (c < 2) ? SA : (((c >= 6 && c < 9) || (c >= 15 && c < 18)) ? SB : 1.0f); }
#pragma unroll
        for (int ai = 0; ai < 2; ++ai)
#pragma unroll
            for (int m = 0; m < 4; ++m) { bf16_t* rowp = O + (size_t)(row0 + ai * HALF + m * 16) * ldc + col0;
#pragma unroll
                for (int bj = 0; bj < 2; ++bj) { const f32x4 v0 = acc[ai][bj][m][0] * scj[bj], v1 = acc[ai][bj][m][1] * scj[bj];
                    u32x4 w; w.x = cvt_pk_bf16(v0[0], v0[1]); w.y = cvt_pk_bf16(v0[2], v0[3]); w.z = cvt_pk_bf16(v1[0], v1[1]); w.w = cvt_pk_bf16(v1[2], v1[3]);
                    *(u32x4*)(rowp + bj * HALF) = w; } }
    }
};
template <class Epi, class Sched, bool ALIGN_EPI = false, bool SP2 = false>
__device__ __forceinline__ void gemm_phase(PG8_LAS unsigned char* lds, const Gemm g, const Sched& S, const Epi& E) {
    int tid_ = threadIdx.x; asm volatile("" : "+v"(tid_));
    const int tid = tid_, wid = __builtin_amdgcn_readfirstlane(tid >> 6), lane = tid & 63, wr = wid >> 2, wc = wid & 3, fr = lane & 15, fq = lane >> 4;
    const int K = g.K, nt = K / BK;
    unsigned voffA[2], voffB[2];
#pragma unroll
    for (int i = 0; i < 2; ++i) { int R, C; stage_rc(tid * 16 + i * 8192, R, C); const int Rb = Epi::PERM ? ((R & ~31) + perm32(R & 31)) : R;
        voffA[i] = (unsigned)(R * K + C) * 2u; voffB[i] = (unsigned)(Rb * K + C) * 2u; }
    const size_t kstep = (size_t)(BK * 2);
    const size_t hstep = (size_t)HALF * K * 2;
    const size_t tstep = 2 * hstep;
    const unsigned ldsw = (unsigned)wid * 1024u;
    const int aoff = lds_byte(wr * 64 + fr, fq * 8), boff = lds_byte(wc * 32 + fr, fq * 8);
#define PG8_SA(b, h) (((b) * 2 + (h)) * HTB)
#define PG8_SB(b, h) ((4 + (b) * 2 + (h)) * HTB)
#define PG8_STAGE(bufoff, gbase, voff) do { _Pragma("unroll") for (int _i = 0; _i < 2; ++_i) \
        __builtin_amdgcn_global_load_lds((const unsigned*)((const char*)(gbase) + (voff)[_i]), (PG8_LAS unsigned*)(lds + (bufoff) + ldsw + _i * 8192), 16, 0, 0); } while (0)
#define PG8_LDA(dst, b, h) do { _Pragma("unroll") for (int m = 0; m < 4; ++m) _Pragma("unroll") for (int k = 0; k < 2; ++k) dst[m][k] = *(const PG8_LAS bf16x8*)(lds + PG8_SA(b, h) + aoff + m * 2048 + k * 1024); } while (0)
#define PG8_LDB(dst, b, h) do { _Pragma("unroll") for (int n = 0; n < 2; ++n) _Pragma("unroll") for (int k = 0; k < 2; ++k) dst[n][k] = *(const PG8_LAS bf16x8*)(lds + PG8_SB(b, h) + boff + n * 2048 + k * 1024); } while (0)
#define PG8_MMA(ai, bj, At, Bt) do { __builtin_amdgcn_s_setprio(1); _Pragma("unroll") for (int m = 0; m < 4; ++m) _Pragma("unroll") for (int n = 0; n < 2; ++n) _Pragma("unroll") for (int k = 0; k < 2; ++k) \
        acc[ai][bj][m][n] = __builtin_amdgcn_mfma_f32_16x16x32_bf16(Bt[n][k], At[m][k], acc[ai][bj][m][n], 0, 0, 0); __builtin_amdgcn_s_setprio(0); } while (0)
#define PG8_WAIT_V(n) asm volatile("s_waitcnt vmcnt(" #n ")" ::: "memory")
#define PG8_WAIT_L(n) asm volatile("s_waitcnt lgkmcnt(" #n ")" ::: "memory")
#define PG8_BAR __builtin_amdgcn_s_barrier()
#define PG8_SCHED __builtin_amdgcn_sched_barrier(0)
    Unit cur, nxt; int ui = 0;
    if (!S.next(0, cur)) return;
    f32x4 acc[2][2][4][2];
#pragma unroll
    for (int a = 0; a < 2; ++a)
#pragma unroll
        for (int b = 0; b < 2; ++b)
#pragma unroll
            for (int m = 0; m < 4; ++m)
#pragma unroll
                for (int n = 0; n < 2; ++n) acc[a][b][m][n] = (f32x4){0.f, 0.f, 0.f, 0.f};
    bf16x8 At[4][2], B0[2][2], B1[2][2];
    const char* cA = (const char*)g.A + (size_t)cur.pm * tstep; const char* cB = (const char*)g.Bt + (size_t)cur.pn * tstep;
    S.a_ready(cur);
    if constexpr (SP2) {
        PG8_STAGE(PG8_SB(0, 0), cB, voffB); PG8_STAGE(PG8_SB(0, 1), cB + hstep, voffB); PG8_STAGE(PG8_SA(0, 0), cA, voffA); PG8_STAGE(PG8_SA(0, 1), cA + hstep, voffA);
        if (wr == 1) PG8_BAR;
        PG8_WAIT_V(2); PG8_BAR;
        PG8_STAGE(PG8_SB(1, 0), cB + kstep, voffB); PG8_STAGE(PG8_SA(1, 0), cA + kstep, voffA); PG8_STAGE(PG8_SB(1, 1), cB + hstep + kstep, voffB);
        PG8_WAIT_V(6); PG8_BAR;
    } else {
        PG8_STAGE(PG8_SB(0, 0), cB, voffB); PG8_STAGE(PG8_SA(0, 0), cA, voffA); PG8_STAGE(PG8_SB(0, 1), cB + hstep, voffB); PG8_STAGE(PG8_SA(0, 1), cA + hstep, voffA);
        if (wr == 1) PG8_BAR;
        PG8_WAIT_V(4); PG8_BAR;
        PG8_STAGE(PG8_SB(1, 0), cB + kstep, voffB); PG8_STAGE(PG8_SA(1, 0), cA + kstep, voffA); PG8_STAGE(PG8_SB(1, 1), cB + hstep + kstep, voffB);
        PG8_WAIT_V(6); PG8_BAR;
    }
    for (;;) {
        const bool has_next = S.next(ui + 1, nxt);
        const char* nA = has_next ? (const char*)g.A + (size_t)nxt.pm * tstep : cA; const char* nB = has_next ? (const char*)g.Bt + (size_t)nxt.pn * tstep : cB;
        for (int t = 0; t < nt; t += 2) {
            const bool last = (t == nt - 2);
            const char* a1 = cA + (size_t)(t + 1) * kstep;
            const char* a2 = last ? nA : cA + (size_t)(t + 2) * kstep; const char* b2 = last ? nB : cB + (size_t)(t + 2) * kstep;
            const char* a3 = a2 + kstep; const char* b3 = b2 + kstep;
            if (last && has_next) S.a_ready(nxt);
            if constexpr (SP2) {
            PG8_LDB(B0, 0, 0); PG8_LDB(B1, 0, 1); PG8_SCHED; PG8_LDA(At, 0, 0); PG8_STAGE(PG8_SA(1, 1), a1 + hstep, voffA);
            PG8_WAIT_V(8); PG8_WAIT_L(0); PG8_BAR; PG8_MMA(0, 0, At, B0); PG8_MMA(0, 1, At, B1); PG8_BAR; PG8_SCHED;
            PG8_LDA(At, 0, 1); PG8_STAGE(PG8_SB(0, 0), b2, voffB); PG8_STAGE(PG8_SB(0, 1), b2 + hstep, voffB); PG8_STAGE(PG8_SA(0, 0), a2, voffA);
            PG8_WAIT_V(8); PG8_WAIT_L(0); PG8_BAR; PG8_MMA(1, 0, At, B0); PG8_MMA(1, 1, At, B1); PG8_BAR; PG8_SCHED;
            PG8_LDB(B0, 1, 0); PG8_LDB(B1, 1, 1); PG8_SCHED; PG8_LDA(At, 1, 0); PG8_STAGE(PG8_SA(0, 1), a2 + hstep, voffA);
            PG8_WAIT_V(8); PG8_WAIT_L(0); PG8_BAR; PG8_MMA(0, 0, At, B0); PG8_MMA(0, 1, At, B1); PG8_BAR; PG8_SCHED;
            PG8_LDA(At, 1, 1); PG8_STAGE(PG8_SB(1, 0), b3, voffB); PG8_STAGE(PG8_SB(1, 1), b3 + hstep, voffB); PG8_STAGE(PG8_SA(1, 0), a3, voffA);
            PG8_WAIT_V(8); PG8_WAIT_L(0); PG8_BAR; PG8_MMA(1, 0, At, B0); PG8_MMA(1, 1, At, B1); PG8_BAR; PG8_SCHED;
            } else {
            PG8_LDB(B0, 0, 0); PG8_SCHED; PG8_LDA(At, 0, 0); PG8_STAGE(PG8_SA(1, 1), a1 + hstep, voffA);
            PG8_WAIT_L(8); PG8_BAR; PG8_WAIT_L(0); PG8_MMA(0, 0, At, B0); PG8_BAR; PG8_SCHED;
            PG8_LDB(B1, 0, 1); PG8_STAGE(PG8_SB(0, 0), b2, voffB);
            PG8_BAR; PG8_WAIT_L(0); PG8_MMA(0, 1, At, B1); PG8_BAR;
            PG8_LDA(At, 0, 1); PG8_STAGE(PG8_SA(0, 0), a2, voffA);
            PG8_BAR; PG8_WAIT_L(0); PG8_MMA(1, 0, At, B0); PG8_BAR; PG8_SCHED;
            PG8_STAGE(PG8_SB(0, 1), b2 + hstep, voffB);
            PG8_WAIT_V(6); PG8_BAR; PG8_MMA(1, 1, At, B1); PG8_BAR;
            PG8_LDB(B0, 1, 0); PG8_SCHED; PG8_LDA(At, 1, 0); PG8_STAGE(PG8_SA(0, 1), a2 + hstep, voffA);
            PG8_WAIT_L(8); PG8_BAR; PG8_WAIT_L(0); PG8_MMA(0, 0, At, B0); PG8_BAR; PG8_SCHED;
            PG8_LDB(B1, 1, 1); PG8_STAGE(PG8_SB(1, 0), b3, voffB);
            PG8_BAR; PG8_WAIT_L(0); PG8_MMA(0, 1, At, B1); PG8_BAR;
            PG8_LDA(At, 1, 1); PG8_STAGE(PG8_SA(1, 0), a3, voffA);
            PG8_BAR; PG8_WAIT_L(0); PG8_MMA(1, 0, At, B0); PG8_BAR; PG8_SCHED;
            PG8_STAGE(PG8_SB(1, 1), b3 + hstep, voffB);
            PG8_WAIT_V(6); PG8_BAR; PG8_MMA(1, 1, At, B1); PG8_BAR;
            }
        }
        if constexpr (ALIGN_EPI) { if (wr == 0) PG8_BAR; }
        if constexpr (!Epi::AFTER_DRAIN) { E(acc, cur, wr, wc, fr, fq); S.done(cur); }
        if (!has_next) break;
#pragma unroll
        for (int a = 0; a < 2; ++a)
#pragma unroll
            for (int b = 0; b < 2; ++b)
#pragma unroll
                for (int m = 0; m < 4; ++m)
#pragma unroll
                    for (int n = 0; n < 2; ++n) acc[a][b][m][n] = (f32x4){0.f, 0.f, 0.f, 0.f};
        cur = nxt; cA = nA; cB = nB; ++ui;
        if constexpr (ALIGN_EPI) { if (wr == 1) PG8_BAR; }
    }
    PG8_WAIT_V(0);
    if constexpr (!ALIGN_EPI) { if (wr == 0) PG8_BAR; }
    PG8_BAR;
    if constexpr (Epi::AFTER_DRAIN) { E.fused(acc, cur, wr, wc, fr, fq, lds, wid, lane); S.done(cur); }
#undef PG8_SA
#undef PG8_SB
#undef PG8_STAGE
#undef PG8_LDA
#undef PG8_LDB
#undef PG8_MMA
#undef PG8_WAIT_V
#undef PG8_WAIT_L
#undef PG8_BAR
#undef PG8_SCHED
}
}
namespace cg = cooperative_groups;
#define LAS __attribute__((address_space(3)))
#define DI __device__ __forceinline__
typedef unsigned short bf16;
typedef short bf16x8 __attribute__((ext_vector_type(8)));
typedef short v4i16_t __attribute__((ext_vector_type(4)));
typedef float f32x16 __attribute__((ext_vector_type(16)));
typedef float f32x4 __attribute__((ext_vector_type(4)));
typedef float f32x2_t __attribute__((ext_vector_type(2)));
typedef __bf16 bf16x2_t __attribute__((ext_vector_type(2)));
typedef unsigned u32x4 __attribute__((ext_vector_type(4)));
typedef unsigned u32x2 __attribute__((ext_vector_type(2)));

constexpr int NWAVES = 8;
constexpr int BATCH = 8, T = 4096, D = 1024, M = BATCH * T, NPROJ = 2560, FF = 2816, NGU = 2 * FF, DEPTH = 2, NMOD = 6 * D;
constexpr int QA = 0, KA = 256, VA = 512, QB = 768, KB = 1152, VB = 1536, QC = 1920, KC = 2304, VC = 2432;
constexpr int OA = 0, OB = 256, OC = 640;
constexpr float LN_EPS = 1e-5f, LOG2E = 1.4426950408889634f, NEGBIG = -1e30f;
constexpr size_t MiB = 1u << 20;
constexpr size_t WS_CTL = 0, CTL_ZERO_BYTES = 1 * MiB, WS_MOD = 1 * MiB, WS_W = 2 * MiB, W_LAYER = 24 * MiB;
constexpr size_t WO_IN = 0, WO_OUT = 5 * MiB, WO_GU = 7 * MiB, WO_DN = 18 * MiB;
constexpr size_t WS_H = 64 * MiB, WS_PROJ = 128 * MiB, WS_MIX = 288 * MiB, WS_ACT = 128 * MiB, WS_END = 352 * MiB;
constexpr int LDS_BYTES = 147456;
constexpr int N_PHASES = 2 + 7 * DEPTH;

DI unsigned cvtpk(float lo, float hi) { f32x2_t v = {lo, hi}; bf16x2_t b = __builtin_convertvector(v, bf16x2_t); return __builtin_bit_cast(unsigned, b); }
DI unsigned f2bf(float f) { unsigned u = __builtin_bit_cast(unsigned, f); return (u + 0x7fffu + ((u >> 16) & 1u)) >> 16; }
DI unsigned pk2(float lo, float hi) { return f2bf(lo) | (f2bf(hi) << 16); }
DI int crow(int r, int h) { return (r & 3) + 8 * (r >> 2) + 4 * h; }
DI float wave_sum(float v) {
#pragma unroll
    for (int o = 1; o < 64; o <<= 1) v += __shfl_xor(v, o);
    return v;
}
DI float slope_of(int idx) { return __builtin_amdgcn_exp2f(-0.5f * (float)(idx + 1)); }

struct Frame {
    LAS unsigned char* lds;
    int tid, lane, wave, G;
    const float *x, *c, *w_ada, *b_ada, *w_in, *lam, *subln_g, *sink, *w_out, *ln_g, *ln_b, *w_gu, *w_down;
    float* out; unsigned char* ws;
    float* mod; bf16 *H, *PROJ, *MIX, *ACT;
};
DI bf16* wptr(const Frame& F, int layer, size_t off) { return (bf16*)(F.ws + WS_W + (size_t)layer * W_LAYER + off); }

DI void p0_transpose_item(const float* W, int N, int K, bf16* WT, int k0, int n0, int drow0, LAS float* scr, int lane) {
#pragma unroll 8
    for (int i = 0; i < 32; ++i) { const int kk = 2 * i + (lane >> 5); scr[kk * 33 + (lane & 31)] = W[(size_t)(k0 + kk) * N + n0 + (lane & 31)]; }
    asm volatile("s_waitcnt lgkmcnt(0)" ::: "memory");
    const int c = lane & 7;
#pragma unroll
    for (int j = 0; j < 4; ++j) { const int n = (lane >> 3) + 8 * j; const LAS float* s = scr + (8 * c) * 33 + n;
        u32x4 o; o.x = pk2(s[0 * 33], s[1 * 33]); o.y = pk2(s[2 * 33], s[3 * 33]); o.z = pk2(s[4 * 33], s[5 * 33]); o.w = pk2(s[6 * 33], s[7 * 33]);
        *(u32x4*)(WT + (size_t)(drow0 + n) * K + k0 + 8 * c) = o; }
    asm volatile("s_waitcnt lgkmcnt(0)" ::: "memory");
}
DI void p0_phase(Frame& F) {
    {
        LAS float* sc = (LAS float*)F.lds;
        LAS float* red = sc + 8192;
        for (int i = F.tid; i < BATCH * D; i += NWAVES * 64) { const float v = F.c[i]; sc[i] = v / (1.0f + __expf(-v)); }
        __syncthreads();
        for (int cgp = blockIdx.x; cgp < DEPTH * (NMOD / 64); cgp += F.G) {
            const int layer = cgp / (NMOD / 64), colb = (cgp % (NMOD / 64)) * 64, col = colb + F.lane;
            const float* w = F.w_ada + (size_t)layer * D * NMOD + col;
            float acc[8];
#pragma unroll
            for (int b = 0; b < 8; ++b) acc[b] = 0.f;
            const int kb = F.wave * 128;
#pragma unroll 8
            for (int k = kb; k < kb + 128; ++k) { const float wv = w[(size_t)k * NMOD];
#pragma unroll
                for (int b = 0; b < 8; ++b) acc[b] += sc[b * D + k] * wv; }
#pragma unroll
            for (int b = 0; b < 8; ++b) red[(F.wave * 8 + b) * 64 + F.lane] = acc[b];
            __syncthreads();
            { const int b = F.wave; float s = 0.f;
#pragma unroll
              for (int w8 = 0; w8 < 8; ++w8) s += red[(w8 * 8 + b) * 64 + F.lane];
              F.mod[((size_t)layer * BATCH + b) * NMOD + col] = s + F.b_ada[(size_t)layer * NMOD + col]; }
            __syncthreads();
        }
    }
    {
        LAS float* scr = (LAS float*)(F.lds + 65536 + F.wave * 8704);
        const int gw = blockIdx.x * NWAVES + F.wave, NGW = F.G * NWAVES;
        constexpr int I_IN = (D / 64) * (NPROJ / 32), I_OUT = (D / 64) * (D / 32), I_GU = (D / 64) * (NGU / 32), I_DN = (FF / 64) * (D / 32), I_L = I_IN + I_OUT + I_GU + I_DN;
        for (int it = gw; it < DEPTH * I_L; it += NGW) {
            const int layer = it / I_L; int r = it % I_L;
            if (r < I_IN) { const int nb = NPROJ / 32, kb = r / nb, n0 = (r % nb) * 32;
                p0_transpose_item(F.w_in + (size_t)layer * D * NPROJ, NPROJ, D, wptr(F, layer, WO_IN), kb * 64, n0, n0, scr, F.lane); continue; } r -= I_IN;
            if (r < I_OUT) { const int nb = D / 32, kb = r / nb, n0 = (r % nb) * 32;
                p0_transpose_item(F.w_out + (size_t)layer * D * D, D, D, wptr(F, layer, WO_OUT), kb * 64, n0, n0, scr, F.lane); continue; } r -= I_OUT;
            if (r < I_GU) { const int nb = NGU / 32, kb = r / nb, n0 = (r % nb) * 32;
                const int isu = n0 >= FF, nn = isu ? n0 - FF : n0, drow = (nn / 128) * 256 + isu * 128 + (nn % 128);
                p0_transpose_item(F.w_gu + (size_t)layer * D * NGU, NGU, D, wptr(F, layer, WO_GU), kb * 64, n0, drow, scr, F.lane); continue; } r -= I_GU;
            { const int nb = D / 32, kb = r / nb, n0 = (r % nb) * 32;
                p0_transpose_item(F.w_down + (size_t)layer * FF * D, D, FF, wptr(F, layer, WO_DN), kb * 64, n0, n0, scr, F.lane); }
        }
    }
}

DI void row_mod_phase(Frame& F, const float* X, const float* sc, const float* sh, bf16* H) {
    const int gw = blockIdx.x * NWAVES + F.wave, NGW = F.G * NWAVES;
    for (int m = gw; m < M; m += NGW) { const int b = m >> 12;
        const f32x4* xr = (const f32x4*)(X + (size_t)m * D) + F.lane; const f32x4* sr = (const f32x4*)(sc + (size_t)b * NMOD) + F.lane; const f32x4* hr = (const f32x4*)(sh + (size_t)b * NMOD) + F.lane;
        u32x2* o8 = (u32x2*)(H + (size_t)m * D) + F.lane;
#pragma unroll
        for (int j = 0; j < 4; ++j) { const f32x4 v = xr[64 * j] * (sr[64 * j] + 1.0f) + hr[64 * j]; u32x2 w; w.x = cvtpk(v.x, v.y); w.y = cvtpk(v.z, v.w); o8[64 * j] = w; } }
}
DI void row_ln_phase(Frame& F, float* X, const float* g, const float* bb, const float* sc, const float* sh, bf16* H) {
    const int gw = blockIdx.x * NWAVES + F.wave, NGW = F.G * NWAVES;
    for (int m = gw; m < M; m += NGW) { const int b = m >> 12;
        f32x4* xr = (f32x4*)(X + (size_t)m * D) + F.lane;
        f32x4 v[4]; float s = 0.f;
#pragma unroll
        for (int j = 0; j < 4; ++j) { v[j] = xr[64 * j]; s += (v[j].x + v[j].y) + (v[j].z + v[j].w); }
        const float mean = wave_sum(s) * (1.f / D); float s2 = 0.f;
#pragma unroll
        for (int j = 0; j < 4; ++j) { v[j] = v[j] - mean; s2 += (v[j].x * v[j].x + v[j].y * v[j].y) + (v[j].z * v[j].z + v[j].w * v[j].w); }
        const float rstd = 1.f / sqrtf(wave_sum(s2) * (1.f / D) + LN_EPS);
        const f32x4* gr = (const f32x4*)g + F.lane; const f32x4* br = (const f32x4*)bb + F.lane;
#pragma unroll
        for (int j = 0; j < 4; ++j) { v[j] = v[j] * rstd * gr[64 * j] + br[64 * j]; xr[64 * j] = v[j]; }
        if (H) { const f32x4* sr = (const f32x4*)(sc + (size_t)b * NMOD) + F.lane; const f32x4* hr = (const f32x4*)(sh + (size_t)b * NMOD) + F.lane; u32x2* o8 = (u32x2*)(H + (size_t)m * D) + F.lane;
#pragma unroll
            for (int j = 0; j < 4; ++j) { const f32x4 h = v[j] * (sr[64 * j] + 1.0f) + hr[64 * j]; u32x2 w; w.x = cvtpk(h.x, h.y); w.y = cvtpk(h.z, h.w); o8[64 * j] = w; } }
    }
}

constexpr int VPITCH = 192;
constexpr int STG_BYTES = 32 * VPITCH;
constexpr int WAVE_LDS = STG_BYTES + 256;
constexpr int ACC_OFF = NWAVES * WAVE_LDS;
static_assert(ACC_OFF + 65536 + 2048 <= 131072, "attention LDS map");


template <int DQ>
DI void band_task(const bf16* Qp, const bf16* Kp, const bf16* Vp, int q0, int qstride, int nq, int k0, int kstride, int nkb, int W, float slope2, float scale2,
                  LAS unsigned char* stg, LAS float* scr, float& m_out, float& l_out, f32x16 (&o)[2], const int lane) {
    const int r32 = lane & 31, hi = lane >> 5;
    const bool qvalid = r32 < nq;
    const int qpos = q0 + r32 * qstride;
    const int qrow = qvalid ? qpos : q0;
    bf16x8 qf[DQ / 16];
#pragma unroll
    for (int ks = 0; ks < DQ / 16; ++ks) qf[ks] = *(const bf16x8*)(Qp + (size_t)qrow * NPROJ + ks * 16 + hi * 8);
    float m = NEGBIG, l = 0.f;
#pragma unroll
    for (int r = 0; r < 16; ++r) { o[0][r] = 0.f; o[1][r] = 0.f; }
    const LAS unsigned char* vbase = stg + (4 * hi + ((lane & 15) >> 2)) * VPITCH + ((lane >> 4) & 1) * 32 + (lane & 3) * 8;
    for (int nb = 0; nb < nkb; ++nb) {
        int kn = k0 + (nb * 32 + r32) * kstride; kn = kn < 0 ? 0 : (kn > T - 1 ? T - 1 : kn);
        bf16x8 kf[DQ / 16];
#pragma unroll
        for (int ks = 0; ks < DQ / 16; ++ks) kf[ks] = *(const bf16x8*)(Kp + (size_t)kn * NPROJ + ks * 16 + hi * 8);
#pragma unroll
        for (int i = 0; i < 4; ++i) { const int vr = (lane >> 3) + 8 * i; int vn = k0 + (nb * 32 + vr) * kstride; vn = vn < 0 ? 0 : (vn > T - 1 ? T - 1 : vn);
            const u32x4 v = *(const u32x4*)(Vp + (size_t)vn * NPROJ + (lane & 7) * 8);
            *(LAS u32x4*)(stg + vr * VPITCH + (lane & 7) * 16) = v; }
        asm volatile("" ::: "memory");
        f32x16 p;
#pragma unroll
        for (int r = 0; r < 16; ++r) p[r] = 0.f;
#pragma unroll
        for (int ks = 0; ks < DQ / 16; ++ks) p = __builtin_amdgcn_mfma_f32_32x32x16_bf16(kf[ks], qf[ks], p, 0, 0, 0);
        float mb = NEGBIG;
        const int kb0 = k0 + (nb * 32 + 4 * hi) * kstride;
#pragma unroll
        for (int r = 0; r < 16; ++r) { const int kp = kb0 + ((r & 3) + 8 * (r >> 2)) * kstride; int dist = qpos - kp; dist = dist < 0 ? -dist : dist;
            const bool ok = qvalid && kp >= 0 && kp < T && dist <= W;
            const float s = ok ? p[r] * scale2 - slope2 * (float)dist : NEGBIG; p[r] = s; mb = fmaxf(mb, s); }
        mb = fmaxf(mb, __shfl_xor(mb, 32));
        const float mn = fmaxf(m, mb), alpha = __builtin_amdgcn_exp2f(m - mn); m = mn;
        float ls = 0.f;
#pragma unroll
        for (int r = 0; r < 16; ++r) { const float e = p[r] > -1e29f ? __builtin_amdgcn_exp2f(p[r] - mn) : 0.f; p[r] = e; ls += e; }
        l = l * alpha + ls;
        asm volatile("" ::: "memory"); if (lane < 32) scr[r32] = alpha; asm volatile("" ::: "memory");
#pragma unroll
        for (int g = 0; g < 4; ++g) { const f32x4 a4 = *(const LAS f32x4*)(scr + 8 * g + 4 * hi);
#pragma unroll
            for (int e = 0; e < 4; ++e) { o[0][4 * g + e] *= a4[e]; o[1][4 * g + e] *= a4[e]; } }
        asm volatile("" ::: "memory");
#pragma unroll
        for (int s = 0; s < 2; ++s) {
            u32x4 pw; pw.x = cvtpk(p[8 * s], p[8 * s + 1]); pw.y = cvtpk(p[8 * s + 2], p[8 * s + 3]); pw.z = cvtpk(p[8 * s + 4], p[8 * s + 5]); pw.w = cvtpk(p[8 * s + 6], p[8 * s + 7]);
            const bf16x8 pa = __builtin_bit_cast(bf16x8, pw);
#pragma unroll
            for (int d0 = 0; d0 < 2; ++d0) {
                const v4i16_t lo = __builtin_amdgcn_ds_read_tr16_b64_v4i16((LAS v4i16_t*)(vbase + s * 16 * VPITCH + d0 * 64));
                const v4i16_t hh = __builtin_amdgcn_ds_read_tr16_b64_v4i16((LAS v4i16_t*)(vbase + s * 16 * VPITCH + 8 * VPITCH + d0 * 64));
                const bf16x8 vf = __builtin_shufflevector(lo, hh, 0, 1, 2, 3, 4, 5, 6, 7);
                o[d0] = __builtin_amdgcn_mfma_f32_32x32x16_bf16(pa, vf, o[d0], 0, 0, 0);
            }
        }
        asm volatile("" ::: "memory");
    }
    m_out = m; l_out = l;
}
DI void bcast_rows(LAS float* scr, float v, float (&out)[16], const int lane) {
    const int hi = lane >> 5;
    asm volatile("" ::: "memory"); if (lane < 32) scr[lane] = v; asm volatile("" ::: "memory");
#pragma unroll
    for (int g = 0; g < 4; ++g) { const f32x4 a4 = *(const LAS f32x4*)(scr + 8 * g + 4 * hi);
#pragma unroll
        for (int e = 0; e < 4; ++e) out[4 * g + e] = a4[e]; }
    asm volatile("" ::: "memory");
}
DI void store_o_tile(const f32x16 (&o)[2], bf16* MIXb  , int row0, int rstride, int col0, LAS unsigned char* stg, const int lane) {
    const int r32 = lane & 31, hi = lane >> 5;
    constexpr int OP = 144;
    asm volatile("" ::: "memory");
#pragma unroll
    for (int d0 = 0; d0 < 2; ++d0)
#pragma unroll
        for (int r = 0; r < 16; ++r) *(LAS unsigned short*)(stg + crow(r, hi) * OP + (d0 * 32 + r32) * 2) = (unsigned short)f2bf(o[d0][r]);
    asm volatile("" ::: "memory");
#pragma unroll
    for (int i = 0; i < 4; ++i) { const int row = (lane >> 3) + 8 * i; const u32x4 v = *(const LAS u32x4*)(stg + row * OP + (lane & 7) * 16);
        *(u32x4*)(MIXb + (size_t)(row0 + row * rstride) * D + col0 + (lane & 7) * 8) = v; }
    asm volatile("" ::: "memory");
}

constexpr int AK_OFF = ACC_OFF, AKB = 64 * 128, AV_OFF = AK_OFF + 2 * AKB, AVP = 192, AVB = 64 * AVP;
static_assert(AV_OFF + 2 * AVB <= 131072, "attention A LDS map");
constexpr float ATHR = 8.0f;
DI float max3f(float a, float b, float c) { return fmaxf(fmaxf(a, b), c); }
DI void attnA_unit(Frame& F, int layer, int b, int h, int qb, float lam_full, float omli, LAS unsigned char* stg, LAS float* scr) {
    const int lane = F.lane, r32 = lane & 31, hi = lane >> 5, tid = F.tid;
    const bf16* base = F.PROJ + (size_t)b * T * NPROJ;
    const float slope2 = slope_of(6 + h) * LOG2E;
    const int Q0 = qb * 256, qw0 = Q0 + F.wave * 32, q_lane = qw0 + r32;
    bf16x8 qf[2][2];
#pragma unroll
    for (int st = 0; st < 2; ++st)
#pragma unroll
        for (int ks = 0; ks < 2; ++ks) qf[st][ks] = *(const bf16x8*)(base + (size_t)q_lane * NPROJ + QA + h * 64 + st * 32 + ks * 16 + hi * 8);
    float brho[16];
#pragma unroll
    for (int r = 0; r < 16; ++r) brho[r] = slope2 * (float)crow(r, hi);
    float m[2] = {0.f, 0.f}, l[2] = {0.f, 0.f};
    f32x16 o[2][2];
#pragma unroll
    for (int st = 0; st < 2; ++st)
#pragma unroll
        for (int d0 = 0; d0 < 2; ++d0)
#pragma unroll
            for (int r = 0; r < 16; ++r) o[st][d0][r] = 0.f;
    const int srow = tid >> 3, sch = tid & 7;
    const bf16* kg = base + (size_t)srow * NPROJ + KA + h * 64 + sch * 8;
    const bf16* vg = base + (size_t)srow * NPROJ + VA + h * 64 + sch * 8;
    LAS unsigned char* kw = F.lds + AK_OFF + srow * 128 + ((sch ^ (srow & 7)) << 4);
    LAS unsigned char* vw = F.lds + AV_OFF + srow * AVP + sch * 16;
    int koff[2][2];
#pragma unroll
    for (int st = 0; st < 2; ++st)
#pragma unroll
        for (int ks = 0; ks < 2; ++ks) koff[st][ks] = AK_OFF + r32 * 128 + (((st * 4 + ks * 2 + hi) ^ (r32 & 7)) << 4);
    const int voff = AV_OFF + (4 * hi + ((lane & 15) >> 2)) * AVP + ((lane >> 4) & 1) * 32 + (lane & 3) * 8;
    constexpr int NT = T / 64;
    auto tile_of = [&](int i) { return i < 4 ? 4 * qb + i : (i < 4 + 4 * qb ? 4 * qb + 3 - i : i); };
    u32x4 kr, vr;
    { const int t0 = tile_of(0); kr = *(const u32x4*)(kg + (size_t)t0 * 64 * NPROJ); vr = *(const u32x4*)(vg + (size_t)t0 * 64 * NPROJ); }
    __syncthreads();
    *(LAS u32x4*)kw = kr; *(LAS u32x4*)vw = vr;
    __syncthreads();
    bool first = true;
#pragma unroll 1
    for (int i = 0; i < NT; ++i) {
        const int t = tile_of(i), buf = i & 1;
        if (i + 1 < NT) { const int tn = tile_of(i + 1); kr = *(const u32x4*)(kg + (size_t)tn * 64 * NPROJ); vr = *(const u32x4*)(vg + (size_t)tn * 64 * NPROJ); }
#pragma unroll 1
        for (int kb = 0; kb < 2; ++kb) {
            const int kblk0 = t * 64 + kb * 32;
            const int rel = kblk0 - qw0;
            bf16x8 pa[2][2];
#pragma unroll
            for (int st = 0; st < 2; ++st) {
                const bf16x8 kf0 = *(const LAS bf16x8*)(F.lds + koff[st][0] + buf * AKB + kb * 4096);
                const bf16x8 kf1 = *(const LAS bf16x8*)(F.lds + koff[st][1] + buf * AKB + kb * 4096);
                f32x16 acc;
                if (rel != 0) {
                    const float dq = (float)(kblk0 - q_lane), bs = -slope2 * fabsf(dq) - m[st], sg = rel < 0 ? 1.0f : -1.0f;
#pragma unroll
                    for (int r = 0; r < 16; ++r) acc[r] = __builtin_fmaf(sg, brho[r], bs);
                    acc = __builtin_amdgcn_mfma_f32_32x32x16_bf16(kf0, qf[st][0], acc, 0, 0, 0);
                    acc = __builtin_amdgcn_mfma_f32_32x32x16_bf16(kf1, qf[st][1], acc, 0, 0, 0);
                } else {
#pragma unroll
                    for (int r = 0; r < 16; ++r) acc[r] = 0.f;
                    acc = __builtin_amdgcn_mfma_f32_32x32x16_bf16(kf0, qf[st][0], acc, 0, 0, 0);
                    acc = __builtin_amdgcn_mfma_f32_32x32x16_bf16(kf1, qf[st][1], acc, 0, 0, 0);
                    const float qs = slope2 * (float)r32;
#pragma unroll
                    for (int r = 0; r < 16; ++r) acc[r] = acc[r] - fabsf(qs - brho[r]) - m[st];
                }
                float mt = max3f(acc[0], acc[1], acc[2]);
#pragma unroll
                for (int r = 3; r < 15; r += 2) mt = max3f(mt, acc[r], acc[r + 1]);
                mt = fmaxf(mt, acc[15]);
                mt = fmaxf(mt, __shfl_xor(mt, 32));
                if (__any(mt > ATHR) || first) {
                    const float d = first ? mt : fmaxf(mt, 0.f), f = first ? 0.f : __builtin_amdgcn_exp2f(-d);
                    m[st] += d; l[st] *= f;
                    float fr[16]; bcast_rows(scr, f, fr, lane);
#pragma unroll
                    for (int r = 0; r < 16; ++r) { o[st][0][r] *= fr[r]; o[st][1][r] *= fr[r]; acc[r] -= d; }
                }
                float ls = 0.f;
#pragma unroll
                for (int r = 0; r < 16; ++r) { acc[r] = __builtin_amdgcn_exp2f(acc[r]); ls += acc[r]; }
                l[st] += ls;
#pragma unroll
                for (int s = 0; s < 2; ++s) { u32x4 pw; pw.x = cvtpk(acc[8 * s], acc[8 * s + 1]); pw.y = cvtpk(acc[8 * s + 2], acc[8 * s + 3]); pw.z = cvtpk(acc[8 * s + 4], acc[8 * s + 5]); pw.w = cvtpk(acc[8 * s + 6], acc[8 * s + 7]);
                    pa[st][s] = __builtin_bit_cast(bf16x8, pw); }
            }
            first = false;
#pragma unroll
            for (int s = 0; s < 2; ++s)
#pragma unroll
                for (int d0 = 0; d0 < 2; ++d0) {
                    const LAS unsigned char* vp = F.lds + voff + buf * AVB + (kb * 32 + s * 16) * AVP + d0 * 64;
                    const v4i16_t lo = __builtin_amdgcn_ds_read_tr16_b64_v4i16((LAS v4i16_t*)vp);
                    const v4i16_t hh = __builtin_amdgcn_ds_read_tr16_b64_v4i16((LAS v4i16_t*)(vp + 8 * AVP));
                    const bf16x8 vf = __builtin_shufflevector(lo, hh, 0, 1, 2, 3, 4, 5, 6, 7);
                    o[0][d0] = __builtin_amdgcn_mfma_f32_32x32x16_bf16(pa[0][s], vf, o[0][d0], 0, 0, 0);
                    o[1][d0] = __builtin_amdgcn_mfma_f32_32x32x16_bf16(pa[1][s], vf, o[1][d0], 0, 0, 0);
                }
        }
        if (i + 1 < NT) { *(LAS u32x4*)(kw + (buf ^ 1) * AKB) = kr; *(LAS u32x4*)(vw + (buf ^ 1) * AVB) = vr; }
        __syncthreads();
    }
    float l0 = l[0] + __shfl_xor(l[0], 32), l1 = l[1] + __shfl_xor(l[1], 32);
    float f0[16], f1[16];
    bcast_rows(scr, 1.0f / l0, f0, lane); bcast_rows(scr, lam_full / l1, f1, lane);
    const float g0 = F.subln_g[layer * 64 + r32] * omli, g1 = F.subln_g[layer * 64 + 32 + r32] * omli;
#pragma unroll
    for (int r = 0; r < 16; ++r) {
        const float a = o[0][0][r] * f0[r] - o[1][0][r] * f1[r], c = o[0][1][r] * f0[r] - o[1][1][r] * f1[r];
        float ss = a * a + c * c;
        ss += __shfl_xor(ss, 1); ss += __shfl_xor(ss, 2); ss += __shfl_xor(ss, 4); ss += __shfl_xor(ss, 8); ss += __shfl_xor(ss, 16);
        const float rs = 1.0f / sqrtf(ss * (1.0f / 64.0f) + LN_EPS);
        o[0][0][r] = a * rs * g0; o[0][1][r] = c * rs * g1;
    }
    store_o_tile(o[0], F.MIX + (size_t)b * T * D, qw0, 1, OA + h * 64, stg, lane);
}
DI void attnC_task(Frame& F, int layer, int b, int hq, int q0, LAS unsigned char* stg, LAS float* scr) {
    const bf16* base = F.PROJ + (size_t)b * T * NPROJ; const int kvh = hq / 3;
    const float slope2 = slope_of(hq) * LOG2E, scale2 = 1.0f;
    f32x16 o[2]; float m, l;
    band_task<64>(base + QC + hq * 64, base + KC + kvh * 64, base + VC + kvh * 64, q0, 1, 32, q0 - 128, 1, 9, 128, slope2, scale2, stg, scr, m, l, o, F.lane);
    l += __shfl_xor(l, 32);
    const float sk2 = F.sink[layer * 6 + hq] * LOG2E, mx = fmaxf(m, sk2), a = __builtin_amdgcn_exp2f(m - mx);
    const float f = a / (l * a + __builtin_amdgcn_exp2f(sk2 - mx));
    float fr[16]; bcast_rows(scr, f, fr, F.lane);
#pragma unroll
    for (int r = 0; r < 16; ++r) { o[0][r] *= fr[r]; o[1][r] *= fr[r]; }
    store_o_tile(o, F.MIX + (size_t)b * T * D, q0, 1, OC + hq * 64, stg, F.lane);
}
template <int PS>
DI void attnB_pass(Frame& F, const bf16* Qp, const bf16* Kp, const bf16* Vp, bf16* MIXb, int colo, int p0, float slope2, float scale2, LAS unsigned char* stg, LAS float* scr) {
    constexpr int dil = PS == 0 ? 16 : (PS == 1 ? 4 : 1), ntask = PS == 0 ? 16 : 8, nq = PS == 0 ? 16 : 32;
    LAS float* accO = (LAS float*)(F.lds + ACC_OFF); LAS float* accM = accO + 256 * 64; LAS float* accL = accM + 256;
    const int lane = F.lane, r32 = lane & 31, hi = lane >> 5;
#pragma unroll 1
    for (int t = F.wave; t < ntask; t += NWAVES) {
        int qfirst;
        if (PS == 0) qfirst = p0 + t; else if (PS == 1) qfirst = p0 + (t & 3) + 128 * (t >> 2); else qfirst = p0 + 32 * t;
        f32x16 o[2]; float m, l;
        band_task<64>(Qp, Kp, Vp, qfirst, dil, nq, qfirst - 64 * dil, dil, 5, 64 * dil, slope2, scale2, stg, scr, m, l, o, F.lane);
        l += __shfl_xor(l, 32);
        const int rowloc0 = qfirst - p0;
        const int qloc = rowloc0 + r32 * dil;
        float fo = 0.f, ft = 1.f, mn = m, ln = l;
        if (PS > 0) { const float mo = accM[qloc], lo = accL[qloc]; mn = fmaxf(mo, m); fo = __builtin_amdgcn_exp2f(mo - mn); ft = __builtin_amdgcn_exp2f(m - mn); ln = lo * fo + l * ft; }
        if (PS == 2) { const float inv = 1.0f / ln; fo *= inv; ft *= inv; }
        else if (lane < nq) { accM[qloc] = mn; accL[qloc] = ln; }
        if (PS == 0) {
#pragma unroll
            for (int r = 0; r < 8; ++r) { LAS float* ap = accO + (rowloc0 + crow(r, hi) * dil) * 64 + r32; ap[0] = o[0][r]; ap[32] = o[1][r]; }
        } else {
            float fo_r[16], ft_r[16];
            bcast_rows(scr, fo, fo_r, F.lane); bcast_rows(scr, ft, ft_r, F.lane);
#pragma unroll
            for (int r = 0; r < 16; ++r) { LAS float* ap = accO + (rowloc0 + crow(r, hi) * dil) * 64 + r32;
                const float a0 = ap[0] * fo_r[r] + o[0][r] * ft_r[r], a1 = ap[32] * fo_r[r] + o[1][r] * ft_r[r];
                if (PS == 1) { ap[0] = a0; ap[32] = a1; } else { o[0][r] = a0; o[1][r] = a1; } }
            if (PS == 2) store_o_tile(o, MIXb, qfirst, 1, colo, stg, F.lane);
        }
    }
}
DI void attnB_unit(Frame& F, int b, int hb, int p0, LAS unsigned char* stg, LAS float* scr) {
    const bf16* base = F.PROJ + (size_t)b * T * NPROJ;
    const bf16 *Qp = base + QB + hb * 64, *Kp = base + KB + hb * 64, *Vp = base + VB + hb * 64;
    bf16* MIXb = F.MIX + (size_t)b * T * D;
    const float slope2 = slope_of(10 + hb) * LOG2E, scale2 = 1.0f;
    __syncthreads();
    attnB_pass<0>(F, Qp, Kp, Vp, MIXb, OB + hb * 64, p0, slope2, scale2, stg, scr);
    __syncthreads();
    attnB_pass<1>(F, Qp, Kp, Vp, MIXb, OB + hb * 64, p0, slope2, scale2, stg, scr);
    __syncthreads();
    attnB_pass<2>(F, Qp, Kp, Vp, MIXb, OB + hb * 64, p0, slope2, scale2, stg, scr);
}
DI void attn_phase(Frame& F, int layer) {
    LAS unsigned char* stg = F.lds + F.wave * WAVE_LDS; LAS float* scr = (LAS float*)(stg + STG_BYTES);
    const float* lam = F.lam + layer * 128;
    float d1 = F.lane < 32 ? lam[F.lane] * lam[32 + F.lane] : 0.f, d2 = F.lane < 32 ? lam[64 + F.lane] * lam[96 + F.lane] : 0.f;
    d1 = wave_sum(d1); d2 = wave_sum(d2);
    const float lambda_init = 0.8f - 0.6f * __expf(-0.3f * (float)layer);
    const float lam_full = __expf(d1) - __expf(d2) + lambda_init, omli = 1.0f - lambda_init;
    constexpr int NU_A = BATCH * 4 * (T / 256), NU_C = BATCH * (T / 256), NU_B = BATCH * 6 * (T / 256);
    for (int u = blockIdx.x; u < NU_A + NU_C + NU_B; u += F.G) {
        { int t_ = threadIdx.x; asm volatile("" : "+v"(t_)); F.tid = t_; F.lane = t_ & 63; }
#ifndef ATTSEL
#define ATTSEL 7
#endif
        if (u < NU_A) { if (ATTSEL & 1) { const int b = u / 64, h = (u / 16) & 3, qb = u & 15; attnA_unit(F, layer, b, h, qb, lam_full, omli, stg, scr); } }
        else if (u < NU_A + NU_C) { if (ATTSEL & 2) { const int uc = u - NU_A, b = uc / 16, qb = uc & 15;
#pragma unroll 1
            for (int hq = 0; hq < 6; ++hq) attnC_task(F, layer, b, hq, qb * 256 + F.wave * 32, stg, scr); } }
        else if (ATTSEL & 4) { const int ub = u - NU_A - NU_C, b = ub / 96, hb = (ub / 16) % 6, pb = ub & 15; attnB_unit(F, b, hb, pb * 256, stg, scr); }
    }
}

struct Args { const float* in[13]; float* out; unsigned char* ws; int ph_lo, ph_hi; };
__global__ void __launch_bounds__(NWAVES * 64, 2) fwd(Args args) {
    extern __shared__ __attribute__((aligned(16))) unsigned char lds[];
    Frame F;
    F.lds = (LAS unsigned char*)lds;
    F.tid = threadIdx.x; F.lane = F.tid & 63; F.wave = __builtin_amdgcn_readfirstlane(F.tid >> 6); F.G = gridDim.x;
    F.x = args.in[0]; F.c = args.in[1]; F.w_ada = args.in[2]; F.b_ada = args.in[3]; F.w_in = args.in[4]; F.lam = args.in[5]; F.subln_g = args.in[6];
    F.sink = args.in[7]; F.w_out = args.in[8]; F.ln_g = args.in[9]; F.ln_b = args.in[10]; F.w_gu = args.in[11]; F.w_down = args.in[12];
    F.out = args.out; F.ws = args.ws;
    F.mod = (float*)(args.ws + WS_MOD); F.H = (bf16*)(args.ws + WS_H); F.PROJ = (bf16*)(args.ws + WS_PROJ); F.MIX = (bf16*)(args.ws + WS_MIX); F.ACT = (bf16*)(args.ws + WS_ACT);
    cg::grid_group grid = cg::this_grid();
    const int lo = args.ph_lo, hi = args.ph_hi;
    const float alpha = 1.4142135623730951f;
#ifndef PHMASK
#define PHMASK 0x1ff
#endif
#define IN(k) (lo <= (k) && (k) < hi)
#define INM(bit, k) (((PHMASK >> (bit)) & 1) && IN(k))
#define RELANE() do { int t_ = threadIdx.x; asm volatile("" : "+v"(t_)); F.tid = t_; F.lane = t_ & 63; } while (0)
#define SEAM(k) do { if (IN(k) && IN((k) + 1)) grid.sync(); } while (0)
    if (INM(0, 0)) { RELANE(); p0_phase(F); } SEAM(0);
    if (INM(1, 1)) { RELANE(); row_mod_phase(F, F.x, F.mod + 1 * D, F.mod + 0 * D, F.H); } SEAM(1);
#pragma unroll 1
    for (int layer = 0; layer < DEPTH; ++layer) {
        const int pb = 2 + 7 * layer;
        const float* modl = F.mod + (size_t)layer * BATCH * NMOD;
        if (INM(2, pb + 0)) {
            pg8::Gemm g{F.H, wptr(F, layer, WO_IN), M, NPROJ, D}; pg8::StaticOrder S; S.init(M, NPROJ, F.G, (int)blockIdx.x);
            pg8::EpiProj E{F.PROJ, NPROJ};
            pg8::gemm_phase<pg8::EpiProj, pg8::StaticOrder, true, true>(F.lds, g, S, E);
        } SEAM(pb + 0);
        if (INM(3, pb + 1)) { RELANE(); attn_phase(F, layer); } SEAM(pb + 1);
        if (INM(4, pb + 2)) {
            pg8::Gemm g{F.MIX, wptr(F, layer, WO_OUT), M, D, D}; pg8::StaticOrder S; S.init(M, D, F.G, (int)blockIdx.x);
            pg8::EpiResid E{layer == 0 ? F.x : F.out, F.out, modl + 2 * D, alpha};
            pg8::gemm_phase<pg8::EpiResid, pg8::StaticOrder, true, true>(F.lds, g, S, E);
        } SEAM(pb + 2);
        if (INM(5, pb + 3)) { RELANE(); row_ln_phase(F, F.out, F.ln_g + (size_t)(layer * 2 + 0) * D, F.ln_b + (size_t)(layer * 2 + 0) * D, modl + 4 * D, modl + 3 * D, F.H); } SEAM(pb + 3);
        if (INM(6, pb + 4)) {
            pg8::Gemm g{F.H, wptr(F, layer, WO_GU), M, NGU, D}; pg8::StaticOrder S; S.init(M, NGU, F.G, (int)blockIdx.x);
            pg8::EpiSwiGLU E{F.ACT, FF};
            pg8::gemm_phase<pg8::EpiSwiGLU, pg8::StaticOrder, true, true>(F.lds, g, S, E);
        } SEAM(pb + 4);
        if (INM(7, pb + 5)) {
            pg8::Gemm g{F.ACT, wptr(F, layer, WO_DN), M, D, FF}; pg8::StaticOrder S; S.init(M, D, F.G, (int)blockIdx.x);
            pg8::EpiResid E{F.out, F.out, modl + 5 * D, alpha};
            pg8::gemm_phase<pg8::EpiResid, pg8::StaticOrder, true, true>(F.lds, g, S, E);
        } SEAM(pb + 5);
        if (INM(8, pb + 6)) { const bool last = layer == DEPTH - 1; const float* modn = modl + (size_t)BATCH * NMOD;
            RELANE(); row_ln_phase(F, F.out, F.ln_g + (size_t)(layer * 2 + 1) * D, F.ln_b + (size_t)(layer * 2 + 1) * D, modn + 1 * D, modn + 0 * D, last ? (bf16*)nullptr : F.H); }
        SEAM(pb + 6);
    }
#undef IN
#undef SEAM
}

#ifndef MK_FUSED
#define MK_FUSED 0
#endif
extern "C" void kernel_launch(void* const* d_in, const int* in_sizes, int n_in, void* d_out, int out_size, void* d_ws, size_t ws_size, hipStream_t stream) {
    static int grid = 0;
    if (grid == 0) {
        if (n_in != 13 || in_sizes[0] != M * D || out_size != M * D || ws_size < WS_END) { fprintf(stderr, "kernel_launch: unexpected shapes (n_in %d, in0 %d, out %d, ws %zu)\n", n_in, n_in > 0 ? in_sizes[0] : -1, out_size, ws_size); grid = -1; return; }
        int dev = 0, cus = 0, per_cu = 0;
        if (hipGetDevice(&dev) != hipSuccess || hipDeviceGetAttribute(&cus, hipDeviceAttributeMultiprocessorCount, dev) != hipSuccess) { grid = -1; return; }
        if (hipFuncSetAttribute((const void*)fwd, hipFuncAttributeMaxDynamicSharedMemorySize, LDS_BYTES) != hipSuccess) { fprintf(stderr, "kernel_launch: hipFuncSetAttribute failed\n"); grid = -1; return; }
        if (hipOccupancyMaxActiveBlocksPerMultiprocessor(&per_cu, (const void*)fwd, NWAVES * 64, LDS_BYTES) != hipSuccess || per_cu < 1) { fprintf(stderr, "kernel_launch: occupancy query says %d blocks per CU\n", per_cu); per_cu = 1; }
        (void)hipGetLastError();
        grid = cus;
    }
    if (grid < 0) return;
    Args a{};
    for (int i = 0; i < 13; ++i) a.in[i] = (const float*)d_in[i];
    a.out = (float*)d_out; a.ws = (unsigned char*)d_ws;
#if MK_FUSED
    a.ph_lo = 0; a.ph_hi = N_PHASES;
    void* kargs[] = {&a};
    hipError_t e = hipLaunchCooperativeKernel((const void*)fwd, dim3(grid), dim3(NWAVES * 64), kargs, LDS_BYTES, stream);
    if (e != hipSuccess) fprintf(stderr, "kernel_launch: cooperative launch failed: %s (grid %d)\n", hipGetErrorString(e), grid);
#else
    for (int p = 0; p < N_PHASES; ++p) { a.ph_lo = p; a.ph_hi = p + 1; hipLaunchKernelGGL(fwd, dim3(grid), dim3(NWAVES * 64), LDS_BYTES, stream, a); }
#endif
}
```

```cpp
#include <hip/hip_runtime.h>
#include <hip/hip_cooperative_groups.h>
#include <cstdio>
#include <cstdint>
#define MK_FUSED 1

namespace pg8 {
#define PG8_LAS __attribute__((address_space(3)))
typedef unsigned short bf16_t;
typedef short bf16x8 __attribute__((ext_vector_type(8)));
typedef float f32x4 __attribute__((ext_vector_type(4)));
typedef unsigned u32x4 __attribute__((ext_vector_type(4)));
constexpr int BM = 256, BK = 64, HALF = 128, HTB = HALF * BK * 2  , STAGE_BYTES = 8 * HTB, NXCD = 8, WGM = 8;

__host__ __device__ __forceinline__ int lds_byte(int r, int c) { const int st = (r >> 4) * 2 + (c >> 5), rr = r & 15, cc = c & 31, ob = rr * 64 + cc * 2; return st * 1024 + (ob ^ (((ob >> 9) & 1) << 5)); }
__host__ __device__ __forceinline__ void stage_rc(int b, int& R, int& C) { const int st = b / 1024, sb = b % 1024, swz = sb ^ (((sb >> 9) & 1) << 5); R = (st >> 1) * 16 + swz / 64; C = (st & 1) * 32 + (swz % 64) / 2; }
__host__ __device__ __forceinline__ int perm32(int rho) { const int n = rho >> 4, i = rho & 15; return 8 * (i >> 2) + 4 * n + (i & 3); }

struct Unit { int pm, pn; };
struct Gemm { const bf16_t* A; const bf16_t* Bt; int M, N, K; };

struct StaticOrder {
    int nM, nN, nwg, G, c;
    __host__ __device__ void init(int M, int N, int G_, int c_) { nM = M / BM; nN = N / BM; nwg = nM * nN; G = G_; c = c_; }
    __host__ __device__ bool next(int i, Unit& u) const {
        const long L = (long)i * G + c; if (L >= nwg) return false;
        int wgid = (int)L; { const int q = nwg / NXCD, r = nwg % NXCD, xcd = wgid % NXCD, off = wgid / NXCD; wgid = (xcd < r ? xcd * (q + 1) : r * (q + 1) + (xcd - r) * q) + off; }
        const int nig = WGM * nN, gid = wgid / nig, fm = gid * WGM, gsz = (nM - fm) < WGM ? (nM - fm) : WGM;
        u.pm = fm + ((wgid % nig) % gsz); u.pn = (wgid % nig) / gsz; return true;
    }
    __device__ __forceinline__ void a_ready(const Unit&) const {}
    __device__ __forceinline__ void done(const Unit&) const {}
};

__device__ __forceinline__ unsigned cvt_pk_bf16(float lo, float hi) { unsigned r; asm volatile("v_cvt_pk_bf16_f32 %0, %1, %2" : "=v"(r) : "v"(lo), "v"(hi)); return r; }
typedef float f32x2 __attribute__((ext_vector_type(2)));
__device__ __forceinline__ f32x2 gelu_pk(f32x2 v) {
    const f32x2 av = __builtin_elementwise_abs(v), d = av * 0.2316418882f + 1.0f;
    f32x2 t; t.x = __builtin_amdgcn_rcpf(d.x); t.y = __builtin_amdgcn_rcpf(d.y);
    f32x2 q = t * 0.5307027145f + (-0.7265760135f); q = q * t + 0.7107068705f; q = q * t + (-0.142248368f); q = q * t + 0.127414796f; q = q * t;
    const f32x2 s = (v * v) * (-0.72134752044f);
    f32x2 e; e.x = __builtin_amdgcn_exp2f(s.x); e.y = __builtin_amdgcn_exp2f(s.y);
    const f32x2 m = v * (q * e), r = v - m;
    f32x2 o; o.x = v.x < 0.f ? m.x : r.x; o.y = v.y < 0.f ? m.y : r.y; return o;
}

template <int ACT  > struct EpiBf16 {
    static constexpr bool PERM = true, AFTER_DRAIN = false; static_assert(ACT == 0 || ACT == 1, "EpiBf16: ACT is 0 (none) or 1 (gelu_pk)");
    bf16_t* O; int ldc; const float* bias; int split_cols; size_t split_stride; float scale0;
    __device__ __forceinline__ void operator()(const f32x4 (&acc)[2][2][4][2], const Unit& u, int wr, int wc, int fr, int fq) const {
        const int row0 = u.pm * BM + wr * 64 + fr; int colt = u.pn * BM; bf16_t* base = O;
        float sc = 1.f; if (split_cols) { const int t = colt / split_cols; base += (size_t)t * split_stride; colt -= t * split_cols; if (t == 0) sc = scale0; }
        const int col0 = colt + wc * 32 + 8 * fq, bcol0 = u.pn * BM + wc * 32 + 8 * fq;
        f32x4 bv[2][2];
#pragma unroll
        for (int bj = 0; bj < 2; ++bj)
#pragma unroll
            for (int n = 0; n < 2; ++n) bv[bj][n] = bias ? *(const f32x4*)(bias + bcol0 + bj * HALF + 4 * n) : (f32x4){0.f, 0.f, 0.f, 0.f};
#pragma unroll
        for (int ai = 0; ai < 2; ++ai)
#pragma unroll
            for (int m = 0; m < 4; ++m) { bf16_t* rowp = base + (size_t)(row0 + ai * HALF + m * 16) * ldc + col0;
#pragma unroll
                for (int bj = 0; bj < 2; ++bj) { f32x4 v0 = acc[ai][bj][m][0] + bv[bj][0], v1 = acc[ai][bj][m][1] + bv[bj][1];
                    if (ACT == 1) { f32x2 a = gelu_pk((f32x2){v0[0], v0[1]}), b = gelu_pk((f32x2){v0[2], v0[3]}), c = gelu_pk((f32x2){v1[0], v1[1]}), d = gelu_pk((f32x2){v1[2], v1[3]});
                        v0 = (f32x4){a.x, a.y, b.x, b.y}; v1 = (f32x4){c.x, c.y, d.x, d.y}; }
                    v0 = v0 * sc; v1 = v1 * sc; u32x4 w; w.x = cvt_pk_bf16(v0[0], v0[1]); w.y = cvt_pk_bf16(v0[2], v0[3]); w.z = cvt_pk_bf16(v1[0], v1[1]); w.w = cvt_pk_bf16(v1[2], v1[3]);
                    *(u32x4*)(rowp + bj * HALF) = w; } }
    }
};
struct EpiResid {
    static constexpr bool PERM = false, AFTER_DRAIN = false;
    const float* X; float* Y; const float* gate; float alpha;
    __device__ __forceinline__ void operator()(const f32x4 (&acc)[2][2][4][2], const Unit& u, int wr, int wc, int fr, int fq) const {
        const int row0 = u.pm * BM + wr * 64 + fr, col0 = u.pn * BM + wc * 32 + 4 * fq;
        const float* gp = gate + (size_t)(u.pm >> 4) * 6144 + col0;
        f32x4 gv[2][2];
#pragma unroll
        for (int bj = 0; bj < 2; ++bj)
#pragma unroll
            for (int n = 0; n < 2; ++n) gv[bj][n] = *(const f32x4*)(gp + bj * HALF + n * 16) + 1.0f;
#pragma unroll
        for (int ai = 0; ai < 2; ++ai)
#pragma unroll
            for (int m = 0; m < 4; ++m) { const size_t off = (size_t)(row0 + ai * HALF + m * 16) * 1024 + col0;
#pragma unroll
                for (int bj = 0; bj < 2; ++bj)
#pragma unroll
                    for (int n = 0; n < 2; ++n) { const f32x4 x = *(const f32x4*)(X + off + bj * HALF + n * 16);
                        *(f32x4*)(Y + off + bj * HALF + n * 16) = x * alpha + gv[bj][n] * acc[ai][bj][m][n]; } }
    }
};
struct EpiSwiGLU {
    static constexpr bool PERM = true, AFTER_DRAIN = false;
    bf16_t* O; int ldc;
    __device__ __forceinline__ void operator()(const f32x4 (&acc)[2][2][4][2], const Unit& u, int wr, int wc, int fr, int fq) const {
        const int row0 = u.pm * BM + wr * 64 + fr, col0 = u.pn * HALF + wc * 32 + 8 * fq;
#pragma unroll
        for (int ai = 0; ai < 2; ++ai)
#pragma unroll
            for (int m = 0; m < 4; ++m) { bf16_t* rowp = O + (size_t)(row0 + ai * HALF + m * 16) * ldc + col0;
                float r[8];
#pragma unroll
                for (int n = 0; n < 2; ++n)
#pragma unroll
                    for (int e = 0; e < 4; ++e) { const float g = acc[ai][0][m][n][e], uu = acc[ai][1][m][n][e];
                        r[4 * n + e] = g * __builtin_amdgcn_rcpf(1.0f + __builtin_amdgcn_exp2f(-1.4426950408889634f * g)) * uu; }
                u32x4 w; w.x = cvt_pk_bf16(r[0], r[1]); w.y = cvt_pk_bf16(r[2], r[3]); w.z = cvt_pk_bf16(r[4], r[5]); w.w = cvt_pk_bf16(r[6], r[7]);
                *(u32x4*)rowp = w; }
    }
};

struct EpiProj {
    static constexpr bool PERM = true, AFTER_DRAIN = false;
    bf16_t* O; int ldc;
    __device__ __forceinline__ void operator()(const f32x4 (&acc)[2][2][4][2], const Unit& u, int wr, int wc, int fr, int fq) const {
        const int row0 = u.pm * BM + wr * 64 + fr, col0 = u.pn * BM + wc * 32 + 8 * fq;
        const float SA = 0.17677669529663687f * 1.4426950408889634f, SB = 0.125f * 1.4426950408889634f;
        float scj[2];
#pragma unroll
        for (int bj = 0; bj < 2; ++bj) { const int c = u.pn * 2 + bj;
            scj[bj] = (c < 2) ? SA : (((c >= 6 && c < 9) || (c >= 15 && c < 18)) ? SB : 1.0f); }
#pragma unroll
        for (int ai = 0; ai < 2; ++ai)
#pragma unroll
            for (int m = 0; m < 4; ++m) { bf16_t* rowp = O + (size_t)(row0 + ai * HALF + m * 16) * ldc + col0;
#pragma unroll
                for (int bj = 0; bj < 2; ++bj) { const f32x4 v0 = acc[ai][bj][m][0] * scj[bj], v1 = acc[ai][bj][m][1] * scj[bj];
                    u32x4 w; w.x = cvt_pk_bf16(v0[0], v0[1]); w.y = cvt_pk_bf16(v0[2], v0[3]); w.z = cvt_pk_bf16(v1[0], v1[1]); w.w = cvt_pk_bf16(v1[2], v1[3]);
                    *(u32x4*)(rowp + bj * HALF) = w; } }
    }
};
template <class Epi, class Sched, bool ALIGN_EPI = false, bool SP2 = false>
__device__ __forceinline__ void gemm_phase(PG8_LAS unsigned char* lds, const Gemm g, const Sched& S, const Epi& E) {
    int tid_ = threadIdx.x; asm volatile("" : "+v"(tid_));
    const int tid = tid_, wid = __builtin_amdgcn_readfirstlane(tid >> 6), lane = tid & 63, wr = wid >> 2, wc = wid & 3, fr = lane & 15, fq = lane >> 4;
    const int K = g.K, nt = K / BK;
    unsigned voffA[2], voffB[2];
#pragma unroll
    for (int i = 0; i < 2; ++i) { int R, C; stage_rc(tid * 16 + i * 8192, R, C); const int Rb = Epi::PERM ? ((R & ~31) + perm32(R & 31)) : R;
        voffA[i] = (unsigned)(R * K + C) * 2u; voffB[i] = (unsigned)(Rb * K + C) * 2u; }
    const size_t kstep = (size_t)(BK * 2);
    const size_t hstep = (size_t)HALF * K * 2;
    const size_t tstep = 2 * hstep;
    const unsigned ldsw = (unsigned)wid * 1024u;
    const int aoff = lds_byte(wr * 64 + fr, fq * 8), boff = lds_byte(wc * 32 + fr, fq * 8);
#define PG8_SA(b, h) (((b) * 2 + (h)) * HTB)
#define PG8_SB(b, h) ((4 + (b) * 2 + (h)) * HTB)
#define PG8_STAGE(bufoff, gbase, voff) do { _Pragma("unroll") for (int _i = 0; _i < 2; ++_i) \
        __builtin_amdgcn_global_load_lds((const unsigned*)((const char*)(gbase) + (voff)[_i]), (PG8_LAS unsigned*)(lds + (bufoff) + ldsw + _i * 8192), 16, 0, 0); } while (0)
#define PG8_LDA(dst, b, h) do { _Pragma("unroll") for (int m = 0; m < 4; ++m) _Pragma("unroll") for (int k = 0; k < 2; ++k) dst[m][k] = *(const PG8_LAS bf16x8*)(lds + PG8_SA(b, h) + aoff + m * 2048 + k * 1024); } while (0)
#define PG8_LDB(dst, b, h) do { _Pragma("unroll") for (int n = 0; n < 2; ++n) _Pragma("unroll") for (int k = 0; k < 2; ++k) dst[n][k] = *(const PG8_LAS bf16x8*)(lds + PG8_SB(b, h) + boff + n * 2048 + k * 1024); } while (0)
#define PG8_MMA(ai, bj, At, Bt) do { __builtin_amdgcn_s_setprio(1); _Pragma("unroll") for (int m = 0; m < 4; ++m) _Pragma("unroll") for (int n = 0; n < 2; ++n) _Pragma("unroll") for (int k = 0; k < 2; ++k) \
        acc[ai][bj][m][n] = __builtin_amdgcn_mfma_f32_16x16x32_bf16(Bt[n][k], At[m][k], acc[ai][bj][m][n], 0, 0, 0); __builtin_amdgcn_s_setprio(0); } while (0)
#define PG8_WAIT_V(n) asm volatile("s_waitcnt vmcnt(" #n ")" ::: "memory")
#define PG8_WAIT_L(n) asm volatile("s_waitcnt lgkmcnt(" #n ")" ::: "memory")
#define PG8_BAR __builtin_amdgcn_s_barrier()
#define PG8_SCHED __builtin_amdgcn_sched_barrier(0)
    Unit cur, nxt; int ui = 0;
    if (!S.next(0, cur)) return;
    f32x4 acc[2][2][4][2];
#pragma unroll
    for (int a = 0; a < 2; ++a)
#pragma unroll
        for (int b = 0; b < 2; ++b)
#pragma unroll
            for (int m = 0; m < 4; ++m)
#pragma unroll
                for (int n = 0; n < 2; ++n) acc[a][b][m][n] = (f32x4){0.f, 0.f, 0.f, 0.f};
    bf16x8 At[4][2], B0[2][2], B1[2][2];
    const char* cA = (const char*)g.A + (size_t)cur.pm * tstep; const char* cB = (const char*)g.Bt + (size_t)cur.pn * tstep;
    S.a_ready(cur);
    if constexpr (SP2) {
        PG8_STAGE(PG8_SB(0, 0), cB, voffB); PG8_STAGE(PG8_SB(0, 1), cB + hstep, voffB); PG8_STAGE(PG8_SA(0, 0), cA, voffA); PG8_STAGE(PG8_SA(0, 1), cA + hstep, voffA);
        if (wr == 1) PG8_BAR;
        PG8_WAIT_V(2); PG8_BAR;
        PG8_STAGE(PG8_SB(1, 0), cB + kstep, voffB); PG8_STAGE(PG8_SA(1, 0), cA + kstep, voffA); PG8_STAGE(PG8_SB(1, 1), cB + hstep + kstep, voffB);
        PG8_WAIT_V(6); PG8_BAR;
    } else {
        PG8_STAGE(PG8_SB(0, 0), cB, voffB); PG8_STAGE(PG8_SA(0, 0), cA, voffA); PG8_STAGE(PG8_SB(0, 1), cB + hstep, voffB); PG8_STAGE(PG8_SA(0, 1), cA + hstep, voffA);
        if (wr == 1) PG8_BAR;
        PG8_WAIT_V(4); PG8_BAR;
        PG8_STAGE(PG8_SB(1, 0), cB + kstep, voffB); PG8_STAGE(PG8_SA(1, 0), cA + kstep, voffA); PG8_STAGE(PG8_SB(1, 1), cB + hstep + kstep, voffB);
        PG8_WAIT_V(6); PG8_BAR;
    }
    for (;;) {
        const bool has_next = S.next(ui + 1, nxt);
        const char* nA = has_next ? (const char*)g.A + (size_t)nxt.pm * tstep : cA; const char* nB = has_next ? (const char*)g.Bt + (size_t)nxt.pn * tstep : cB;
        for (int t = 0; t < nt; t += 2) {
            const bool last = (t == nt - 2);
            const char* a1 = cA + (size_t)(t + 1) * kstep;
            const char* a2 = last ? nA : cA + (size_t)(t + 2) * kstep; const char* b2 = last ? nB : cB + (size_t)(t + 2) * kstep;
            const char* a3 = a2 + kstep; const char* b3 = b2 + kstep;
            if (last && has_next) S.a_ready(nxt);
            if constexpr (SP2) {
            PG8_LDB(B0, 0, 0); PG8_LDB(B1, 0, 1); PG8_SCHED; PG8_LDA(At, 0, 0); PG8_STAGE(PG8_SA(1, 1), a1 + hstep, voffA);
            PG8_WAIT_V(8); PG8_WAIT_L(0); PG8_BAR; PG8_MMA(0, 0, At, B0); PG8_MMA(0, 1, At, B1); PG8_BAR; PG8_SCHED;
            PG8_LDA(At, 0, 1); PG8_STAGE(PG8_SB(0, 0), b2, voffB); PG8_STAGE(PG8_SB(0, 1), b2 + hstep, voffB); PG8_STAGE(PG8_SA(0, 0), a2, voffA);
            PG8_WAIT_V(8); PG8_WAIT_L(0); PG8_BAR; PG8_MMA(1, 0, At, B0); PG8_MMA(1, 1, At, B1); PG8_BAR; PG8_SCHED;
            PG8_LDB(B0, 1, 0); PG8_LDB(B1, 1, 1); PG8_SCHED; PG8_LDA(At, 1, 0); PG8_STAGE(PG8_SA(0, 1), a2 + hstep, voffA);
            PG8_WAIT_V(8); PG8_WAIT_L(0); PG8_BAR; PG8_MMA(0, 0, At, B0); PG8_MMA(0, 1, At, B1); PG8_BAR; PG8_SCHED;
            PG8_LDA(At, 1, 1); PG8_STAGE(PG8_SB(1, 0), b3, voffB); PG8_STAGE(PG8_SB(1, 1), b3 + hstep, voffB); PG8_STAGE(PG8_SA(1, 0), a3, voffA);
            PG8_WAIT_V(8); PG8_WAIT_L(0); PG8_BAR; PG8_MMA(1, 0, At, B0); PG8_MMA(1, 1, At, B1); PG8_BAR; PG8_SCHED;
            } else {
            PG8_LDB(B0, 0, 0); PG8_SCHED; PG8_LDA(At, 0, 0); PG8_STAGE(PG8_SA(1, 1), a1 + hstep, voffA);
            PG8_WAIT_L(8); PG8_BAR; PG8_WAIT_L(0); PG8_MMA(0, 0, At, B0); PG8_BAR; PG8_SCHED;
            PG8_LDB(B1, 0, 1); PG8_STAGE(PG8_SB(0, 0), b2, voffB);
            PG8_BAR; PG8_WAIT_L(0); PG8_MMA(0, 1, At, B1); PG8_BAR;
            PG8_LDA(At, 0, 1); PG8_STAGE(PG8_SA(0, 0), a2, voffA);
            PG8_BAR; PG8_WAIT_L(0); PG8_MMA(1, 0, At, B0); PG8_BAR; PG8_SCHED;
            PG8_STAGE(PG8_SB(0, 1), b2 + hstep, voffB);
            PG8_WAIT_V(6); PG8_BAR; PG8_MMA(1, 1, At, B1); PG8_BAR;
            PG8_LDB(B0, 1, 0); PG8_SCHED; PG8_LDA(At, 1, 0); PG8_STAGE(PG8_SA(0, 1), a2 + hstep, voffA);
            PG8_WAIT_L(8); PG8_BAR; PG8_WAIT_L(0); PG8_MMA(0, 0, At, B0); PG8_BAR; PG8_SCHED;
            PG8_LDB(B1, 1, 1); PG8_STAGE(PG8_SB(1, 0), b3, voffB);
            PG8_BAR; PG8_WAIT_L(0); PG8_MMA(0, 1, At, B1); PG8_BAR;
            PG8_LDA(At, 1, 1); PG8_STAGE(PG8_SA(1, 0), a3, voffA);
            PG8_BAR; PG8_WAIT_L(0); PG8_MMA(1, 0, At, B0); PG8_BAR; PG8_SCHED;
            PG8_STAGE(PG8_SB(1, 1), b3 + hstep, voffB);
            PG8_WAIT_V(6); PG8_BAR; PG8_MMA(1, 1, At, B1); PG8_BAR;
            }
        }
        if constexpr (ALIGN_EPI) { if (wr == 0) PG8_BAR; }
        if constexpr (!Epi::AFTER_DRAIN) { E(acc, cur, wr, wc, fr, fq); S.done(cur); }
        if (!has_next) break;
#pragma unroll
        for (int a = 0; a < 2; ++a)
#pragma unroll
            for (int b = 0; b < 2; ++b)
#pragma unroll
                for (int m = 0; m < 4; ++m)
#pragma unroll
                    for (int n = 0; n < 2; ++n) acc[a][b][m][n] = (f32x4){0.f, 0.f, 0.f, 0.f};
        cur = nxt; cA = nA; cB = nB; ++ui;
        if constexpr (ALIGN_EPI) { if (wr == 1) PG8_BAR; }
    }
    PG8_WAIT_V(0);
    if constexpr (!ALIGN_EPI) { if (wr == 0) PG8_BAR; }
    PG8_BAR;
    if constexpr (Epi::AFTER_DRAIN) { E.fused(acc, cur, wr, wc, fr, fq, lds, wid, lane); S.done(cur); }
#undef PG8_SA
#undef PG8_SB
#undef PG8_STAGE
#undef PG8_LDA
#undef PG8_LDB
#undef PG8_MMA
#undef PG8_WAIT_V
#undef PG8_WAIT_L
#undef PG8_BAR
#undef PG8_SCHED
}
}
namespace cg = cooperative_groups;
#define LAS __attribute__((address_space(3)))
#define DI __device__ __forceinline__
typedef unsigned short bf16;
typedef short bf16x8 __attribute__((ext_vector_type(8)));
typedef short v4i16_t __attribute__((ext_vector_type(4)));
typedef float f32x16 __attribute__((ext_vector_type(16)));
typedef float f32x4 __attribute__((ext_vector_type(4)));
typedef float f32x2_t __attribute__((ext_vector_type(2)));
typedef __bf16 bf16x2_t __attribute__((ext_vector_type(2)));
typedef unsigned u32x4 __attribute__((ext_vector_type(4)));
typedef unsigned u32x2 __attribute__((ext_vector_type(2)));

constexpr int NWAVES = 8;
constexpr int BATCH = 8, T = 4096, D = 1024, M = BATCH * T, NPROJ = 2560, FF = 2816, NGU = 2 * FF, DEPTH = 2, NMOD = 6 * D;
constexpr int QA = 0, KA = 256, VA = 512, QB = 768, KB = 1152, VB = 1536, QC = 1920, KC = 2304, VC = 2432;
constexpr int OA = 0, OB = 256, OC = 640;
constexpr float LN_EPS = 1e-5f, LOG2E = 1.4426950408889634f, NEGBIG = -1e30f;
constexpr size_t MiB = 1u << 20;
constexpr size_t WS_CTL = 0, CTL_ZERO_BYTES = 1 * MiB, WS_MOD = 1 * MiB, WS_W = 2 * MiB, W_LAYER = 24 * MiB;
constexpr size_t WO_IN = 0, WO_OUT = 5 * MiB, WO_GU = 7 * MiB, WO_DN = 18 * MiB;
constexpr size_t WS_H = 64 * MiB, WS_PROJ = 128 * MiB, WS_MIX = 288 * MiB, WS_ACT = 128 * MiB, WS_END = 352 * MiB;
constexpr int LDS_BYTES = 147456;
constexpr int N_PHASES = 2 + 7 * DEPTH;

DI unsigned cvtpk(float lo, float hi) { f32x2_t v = {lo, hi}; bf16x2_t b = __builtin_convertvector(v, bf16x2_t); return __builtin_bit_cast(unsigned, b); }
DI unsigned f2bf(float f) { unsigned u = __builtin_bit_cast(unsigned, f); return (u + 0x7fffu + ((u >> 16) & 1u)) >> 16; }
DI unsigned pk2(float lo, float hi) { return f2bf(lo) | (f2bf(hi) << 16); }
DI int crow(int r, int h) { return (r & 3) + 8 * (r >> 2) + 4 * h; }
DI float wave_sum(float v) {
#pragma unroll
    for (int o = 1; o < 64; o <<= 1) v += __shfl_xor(v, o);
    return v;
}
DI float slope_of(int idx) { return __builtin_amdgcn_exp2f(-0.5f * (float)(idx + 1)); }

struct Frame {
    LAS unsigned char* lds;
    int tid, lane, wave, G;
    const float *x, *c, *w_ada, *b_ada, *w_in, *lam, *subln_g, *sink, *w_out, *ln_g, *ln_b, *w_gu, *w_down;
    float* out; unsigned char* ws;
    float* mod; bf16 *H, *PROJ, *MIX, *ACT;
};
DI bf16* wptr(const Frame& F, int layer, size_t off) { return (bf16*)(F.ws + WS_W + (size_t)layer * W_LAYER + off); }

DI void p0_transpose_item(const float* W, int N, int K, bf16* WT, int k0, int n0, int drow0, LAS float* scr, int lane) {
#pragma unroll 8
    for (int i = 0; i < 32; ++i) { const int kk = 2 * i + (lane >> 5); scr[kk * 33 + (lane & 31)] = W[(size_t)(k0 + kk) * N + n0 + (lane & 31)]; }
    asm volatile("s_waitcnt lgkmcnt(0)" ::: "memory");
    const int c = lane & 7;
#pragma unroll
    for (int j = 0; j < 4; ++j) { const int n = (lane >> 3) + 8 * j; const LAS float* s = scr + (8 * c) * 33 + n;
        u32x4 o; o.x = pk2(s[0 * 33], s[1 * 33]); o.y = pk2(s[2 * 33], s[3 * 33]); o.z = pk2(s[4 * 33], s[5 * 33]); o.w = pk2(s[6 * 33], s[7 * 33]);
        *(u32x4*)(WT + (size_t)(drow0 + n) * K + k0 + 8 * c) = o; }
    asm volatile("s_waitcnt lgkmcnt(0)" ::: "memory");
}
DI void p0_phase(Frame& F) {
    {
        LAS float* sc = (LAS float*)F.lds;
        LAS float* red = sc + 8192;
        for (int i = F.tid; i < BATCH * D; i += NWAVES * 64) { const float v = F.c[i]; sc[i] = v / (1.0f + __expf(-v)); }
        __syncthreads();
        for (int cgp = blockIdx.x; cgp < DEPTH * (NMOD / 64); cgp += F.G) {
            const int layer = cgp / (NMOD / 64), colb = (cgp % (NMOD / 64)) * 64, col = colb + F.lane;
            const float* w = F.w_ada + (size_t)layer * D * NMOD + col;
            float acc[8];
#pragma unroll
            for (int b = 0; b < 8; ++b) acc[b] = 0.f;
            const int kb = F.wave * 128;
#pragma unroll 8
            for (int k = kb; k < kb + 128; ++k) { const float wv = w[(size_t)k * NMOD];
#pragma unroll
                for (int b = 0; b < 8; ++b) acc[b] += sc[b * D + k] * wv; }
#pragma unroll
            for (int b = 0; b < 8; ++b) red[(F.wave * 8 + b) * 64 + F.lane] = acc[b];
            __syncthreads();
            { const int b = F.wave; float s = 0.f;
#pragma unroll
              for (int w8 = 0; w8 < 8; ++w8) s += red[(w8 * 8 + b) * 64 + F.lane];
              F.mod[((size_t)layer * BATCH + b) * NMOD + col] = s + F.b_ada[(size_t)layer * NMOD + col]; }
            __syncthreads();
        }
    }
    {
        LAS float* scr = (LAS float*)(F.lds + 65536 + F.wave * 8704);
        const int gw = blockIdx.x * NWAVES + F.wave, NGW = F.G * NWAVES;
        constexpr int I_IN = (D / 64) * (NPROJ / 32), I_OUT = (D / 64) * (D / 32), I_GU = (D / 64) * (NGU / 32), I_DN = (FF / 64) * (D / 32), I_L = I_IN + I_OUT + I_GU + I_DN;
        for (int it = gw; it < DEPTH * I_L; it += NGW) {
            const int layer = it / I_L; int r = it % I_L;
            if (r < I_IN) { const int nb = NPROJ / 32, kb = r / nb, n0 = (r % nb) * 32;
                p0_transpose_item(F.w_in + (size_t)layer * D * NPROJ, NPROJ, D, wptr(F, layer, WO_IN), kb * 64, n0, n0, scr, F.lane); continue; } r -= I_IN;
            if (r < I_OUT) { const int nb = D / 32, kb = r / nb, n0 = (r % nb) * 32;
                p0_transpose_item(F.w_out + (size_t)layer * D * D, D, D, wptr(F, layer, WO_OUT), kb * 64, n0, n0, scr, F.lane); continue; } r -= I_OUT;
            if (r < I_GU) { const int nb = NGU / 32, kb = r / nb, n0 = (r % nb) * 32;
                const int isu = n0 >= FF, nn = isu ? n0 - FF : n0, drow = (nn / 128) * 256 + isu * 128 + (nn % 128);
                p0_transpose_item(F.w_gu + (size_t)layer * D * NGU, NGU, D, wptr(F, layer, WO_GU), kb * 64, n0, drow, scr, F.lane); continue; } r -= I_GU;
            { const int nb = D / 32, kb = r / nb, n0 = (r % nb) * 32;
                p0_transpose_item(F.w_down + (size_t)layer * FF * D, D, FF, wptr(F, layer, WO_DN), kb * 64, n0, n0, scr, F.lane); }
        }
    }
}

DI void row_mod_phase(Frame& F, const float* X, const float* sc, const float* sh, bf16* H) {
    const int gw = blockIdx.x * NWAVES + F.wave, NGW = F.G * NWAVES;
    for (int m = gw; m < M; m += NGW) { const int b = m >> 12;
        const f32x4* xr = (const f32x4*)(X + (size_t)m * D) + F.lane; const f32x4* sr = (const f32x4*)(sc + (size_t)b * NMOD) + F.lane; const f32x4* hr = (const f32x4*)(sh + (size_t)b * NMOD) + F.lane;
        u32x2* o8 = (u32x2*)(H + (size_t)m * D) + F.lane;
#pragma unroll
        for (int j = 0; j < 4; ++j) { const f32x4 v = xr[64 * j] * (sr[64 * j] + 1.0f) + hr[64 * j]; u32x2 w; w.x = cvtpk(v.x, v.y); w.y = cvtpk(v.z, v.w); o8[64 * j] = w; } }
}
DI void row_ln_phase(Frame& F, float* X, const float* g, const float* bb, const float* sc, const float* sh, bf16* H) {
    const int gw = blockIdx.x * NWAVES + F.wave, NGW = F.G * NWAVES;
    for (int m = gw; m < M; m += NGW) { const int b = m >> 12;
        f32x4* xr = (f32x4*)(X + (size_t)m * D) + F.lane;
        f32x4 v[4]; float s = 0.f;
#pragma unroll
        for (int j = 0; j < 4; ++j) { v[j] = xr[64 * j]; s += (v[j].x + v[j].y) + (v[j].z + v[j].w); }
        const float mean = wave_sum(s) * (1.f / D); float s2 = 0.f;
#pragma unroll
        for (int j = 0; j < 4; ++j) { v[j] = v[j] - mean; s2 += (v[j].x * v[j].x + v[j].y * v[j].y) + (v[j].z * v[j].z + v[j].w * v[j].w); }
        const float rstd = 1.f / sqrtf(wave_sum(s2) * (1.f / D) + LN_EPS);
        const f32x4* gr = (const f32x4*)g + F.lane; const f32x4* br = (const f32x4*)bb + F.lane;
#pragma unroll
        for (int j = 0; j < 4; ++j) { v[j] = v[j] * rstd * gr[64 * j] + br[64 * j]; xr[64 * j] = v[j]; }
        if (H) { const f32x4* sr = (const f32x4*)(sc + (size_t)b * NMOD) + F.lane; const f32x4* hr = (const f32x4*)(sh + (size_t)b * NMOD) + F.lane; u32x2* o8 = (u32x2*)(H + (size_t)m * D) + F.lane;
#pragma unroll
            for (int j = 0; j < 4; ++j) { const f32x4 h = v[j] * (sr[64 * j] + 1.0f) + hr[64 * j]; u32x2 w; w.x = cvtpk(h.x, h.y); w.y = cvtpk(h.z, h.w); o8[64 * j] = w; } }
    }
}

constexpr int VPITCH = 192;
constexpr int STG_BYTES = 32 * VPITCH;
constexpr int WAVE_LDS = STG_BYTES + 256;
constexpr int ACC_OFF = NWAVES * WAVE_LDS;
static_assert(ACC_OFF + 65536 + 2048 <= 131072, "attention LDS map");

#define GAS __attribute__((address_space(1)))
#define XB_TMO      128
#define XB_XCNT(j)  (256  + 64 * (j))
#define XB_XSUB(j)  (1280 + 64 * (j))
#define XB_XGEN(j)  (2304 + 64 * (j))
#define XB_TOP      3328
#define XB_TOPGEN   3392
#define XCD_BAR_WORDS 3456
#define XB_SPIN_CAP (1u << 18)

__device__ __forceinline__ unsigned xb_ld(unsigned* p)              { return __hip_atomic_load(p, __ATOMIC_RELAXED, __HIP_MEMORY_SCOPE_AGENT); }
__device__ __forceinline__ unsigned xb_add(unsigned* p, unsigned v) { return __hip_atomic_fetch_add(p, v, __ATOMIC_RELAXED, __HIP_MEMORY_SCOPE_AGENT); }
__device__ __forceinline__ unsigned xb_xcc_id() { return (unsigned)__builtin_amdgcn_s_getreg((3 << 11) | 20) & 0xFu; }
#define XB_SPIN(cond, bar) do { unsigned _sp = 0; while (cond) { __builtin_amdgcn_s_sleep(1); \
    if ((++_sp & 255u) == 0u) { if (xb_ld(&(bar)[XB_TMO])) break; if (_sp > XB_SPIN_CAP) { atomicAdd(&(bar)[XB_TMO], 1u); break; } } } } while (0)

struct XcdBarrier {
    unsigned* bar; unsigned x;
    volatile LAS unsigned* st;
};

__device__ __forceinline__ XcdBarrier xcd_barrier_post(unsigned* bar, volatile LAS unsigned* st) {
    XcdBarrier b; b.bar = bar; b.x = xb_xcc_id(); b.st = st;
    if (threadIdx.x == 0) (void)xb_add(&bar[XB_XCNT(b.x)], 1u);
    return b;
}
__device__ __forceinline__ void xcd_barrier_complete(unsigned* bar, unsigned x, unsigned& nloc, unsigned& nx) {
    const unsigned G = gridDim.x * gridDim.y * gridDim.z;
    unsigned sum, cnt, mine, sp = 0u;
    for (;;) {
        sum = 0u; cnt = 0u; mine = 0u;
#pragma unroll
        for (unsigned j = 0; j < 16; ++j) { const unsigned c = xb_ld(&bar[XB_XCNT(j)]); sum += c; cnt += (c > 0u) ? 1u : 0u; mine = (j == x) ? c : mine; }
        if (sum == G) break;
        __builtin_amdgcn_s_sleep(1);
        if ((++sp & 255u) == 0u) { if (xb_ld(&bar[XB_TMO])) break; if (sp > XB_SPIN_CAP) { atomicAdd(&bar[XB_TMO], 1u); break; } }
    }
    nloc = mine > 0u ? mine : 1u; nx = cnt > 0u ? cnt : 1u;
}

__device__ __forceinline__ void xcd_barrier(const XcdBarrier& b) {
    asm volatile("s_waitcnt vmcnt(0)" ::: "memory");
    __syncthreads();
    if (threadIdx.x == 0) {
        unsigned* bar = b.bar;
        __builtin_amdgcn_s_waitcnt(0);
        unsigned nloc = b.st[0], nx = b.st[1];
        if (nloc == 0u) { xcd_barrier_complete(bar, b.x, nloc, nx); b.st[0] = nloc; b.st[1] = nx; }
        const unsigned old = xb_add(&bar[XB_XSUB(b.x)], 1u);
        const unsigned gen = old / nloc;
        if (old + 1u == (gen + 1u) * nloc) {
            __builtin_amdgcn_fence(__ATOMIC_RELEASE, "agent");
            asm volatile("s_waitcnt vmcnt(0)" ::: "memory");
            const unsigned og = xb_add(&bar[XB_TOP], 1u);
            const unsigned tg = og / nx;
            if (og + 1u == (tg + 1u) * nx) xb_add(&bar[XB_TOPGEN], 1u);
            else XB_SPIN(xb_ld(&bar[XB_TOPGEN]) == tg, bar);
            __builtin_amdgcn_fence(__ATOMIC_ACQUIRE, "agent");
            xb_add(&bar[XB_XGEN(b.x)], 1u);
            asm volatile("s_waitcnt vmcnt(0)" ::: "memory");
        } else {
            XB_SPIN(xb_ld(&bar[XB_XGEN(b.x)]) == gen, bar);
            __builtin_amdgcn_fence(__ATOMIC_ACQUIRE, "agent");
            asm volatile("s_waitcnt vmcnt(0)" ::: "memory");
        }
    }
    __syncthreads();
}
#ifndef REP_A
#define REP_A 1
#endif
#ifndef REP_B
#define REP_B 1
#endif
#ifndef REP_C
#define REP_C 1
#endif

DI float max3f(float a, float b, float c) { return fmaxf(fmaxf(a, b), c); }
constexpr float ATHR = 8.0f;
DI void bcast_rows(LAS float* scr, float v, float (&out)[16], const int lane);
template <int NH>
DI void band_block(const bf16x8 (&kf)[4], const bf16x8 (&qf)[NH][4], const int rel, const int Widx, const bool inr, const int kp0, const int dil, const float (&sl)[NH], const float (&rho)[16],
                   float (&m)[NH], float (&l)[NH], bool (&mset)[NH], f32x16 (&o)[NH][2], const LAS unsigned char* vbase, LAS float* scr, const int lane) {
    const int r32 = lane & 31;
#pragma unroll
    for (int hd = 0; hd < NH; ++hd) {
        __builtin_amdgcn_sched_barrier(0);
        f32x16 acc;
        if (inr && rel != 0) {
            const float bs = -sl[hd] * fabsf((float)(rel - r32)) - m[hd], sg = rel < 0 ? sl[hd] : -sl[hd];
#pragma unroll
            for (int r = 0; r < 16; ++r) acc[r] = __builtin_fmaf(sg, rho[r], bs);
        } else {
#pragma unroll
            for (int r = 0; r < 16; ++r) acc[r] = 0.f;
        }
#pragma unroll
        for (int ks = 0; ks < 4; ++ks) acc = __builtin_amdgcn_mfma_f32_32x32x16_bf16(kf[ks], qf[hd][ks], acc, 0, 0, 0);
        if (inr) {
            if (rel == 0) {
#pragma unroll
                for (int r = 0; r < 16; ++r) acc[r] = acc[r] - sl[hd] * fabsf((float)r32 - rho[r]) - m[hd];
            } else if (rel == -Widx) {
#pragma unroll
                for (int r = 0; r < 16; ++r) acc[r] = rho[r] >= (float)r32 ? acc[r] : NEGBIG;
            } else if (rel == Widx) {
#pragma unroll
                for (int r = 0; r < 16; ++r) acc[r] = rho[r] <= (float)r32 ? acc[r] : NEGBIG;
            }
        } else {
#pragma unroll
            for (int r = 0; r < 16; ++r) { const int kp = kp0 + (int)rho[r] * dil; const float di = fabsf((float)(r32 - rel) - rho[r]);
                acc[r] = (kp >= 0 && kp < T && di <= (float)Widx) ? acc[r] - sl[hd] * di - m[hd] : NEGBIG; }
        }
        float mt = max3f(acc[0], acc[1], acc[2]);
#pragma unroll
        for (int r = 3; r < 15; r += 2) mt = max3f(mt, acc[r], acc[r + 1]);
        mt = fmaxf(mt, acc[15]);
        mt = fmaxf(mt, __shfl_xor(mt, 32));
        const bool nonempty = mt > -1e29f;
        if (__any((!mset[hd] && nonempty) || mt > ATHR)) {
            const float d = !mset[hd] ? (nonempty ? mt : 0.f) : fmaxf(mt, 0.f), f = !mset[hd] ? 1.0f : __builtin_amdgcn_exp2f(-d);
            mset[hd] = mset[hd] || nonempty;
            m[hd] += d; l[hd] *= f;
            float fr[16]; bcast_rows(scr, f, fr, lane);
#pragma unroll
            for (int r = 0; r < 16; ++r) { o[hd][0][r] *= fr[r]; o[hd][1][r] *= fr[r]; acc[r] -= d; }
        }
        float ls = 0.f;
#pragma unroll
        for (int r = 0; r < 16; ++r) { acc[r] = __builtin_amdgcn_exp2f(acc[r]); ls += acc[r]; }
        l[hd] += ls;
#pragma unroll
        for (int s = 0; s < 2; ++s) {
            u32x4 pw; pw.x = cvtpk(acc[8 * s], acc[8 * s + 1]); pw.y = cvtpk(acc[8 * s + 2], acc[8 * s + 3]); pw.z = cvtpk(acc[8 * s + 4], acc[8 * s + 5]); pw.w = cvtpk(acc[8 * s + 6], acc[8 * s + 7]);
            const bf16x8 pa = __builtin_bit_cast(bf16x8, pw);
#pragma unroll
            for (int d0 = 0; d0 < 2; ++d0) {
                const v4i16_t lo = __builtin_amdgcn_ds_read_tr16_b64_v4i16((LAS v4i16_t*)(vbase + s * 16 * VPITCH + d0 * 64));
                const v4i16_t hh = __builtin_amdgcn_ds_read_tr16_b64_v4i16((LAS v4i16_t*)(vbase + s * 16 * VPITCH + 8 * VPITCH + d0 * 64));
                const bf16x8 vf = __builtin_shufflevector(lo, hh, 0, 1, 2, 3, 4, 5, 6, 7);
                o[hd][d0] = __builtin_amdgcn_mfma_f32_32x32x16_bf16(pa, vf, o[hd][d0], 0, 0, 0);
            }
        }
    }
}
template <int NH>
DI void band_task2(const bf16* Qp, const bf16* Kp, const bf16* Vp, int qpos0, int dil, int Widx, int nq, const float (&sl)[NH]  ,
                   LAS unsigned char* stg, LAS float* scr, float (&m)[NH], float (&l)[NH], f32x16 (&o)[NH][2], const int lane) {
    const int r32 = lane & 31, hi = lane >> 5;
    int qrow = qpos0 + r32 * dil; qrow = qrow > T - 1 ? T - 1 : qrow;
    bf16x8 qf[NH][4];
#pragma unroll
    for (int hd = 0; hd < NH; ++hd)
#pragma unroll
        for (int ks = 0; ks < 4; ++ks) qf[hd][ks] = *(const bf16x8*)(Qp + (size_t)qrow * NPROJ + hd * 64 + ks * 16 + hi * 8);
    float rho[16];
#pragma unroll
    for (int r = 0; r < 16; ++r) rho[r] = (float)crow(r, hi);
    bool mset[NH];
#pragma unroll
    for (int hd = 0; hd < NH; ++hd) { m[hd] = 0.f; l[hd] = 0.f; mset[hd] = false;
#pragma unroll
        for (int r = 0; r < 16; ++r) { o[hd][0][r] = 0.f; o[hd][1][r] = 0.f; } }
    const LAS unsigned char* vbase = stg + (4 * hi + ((lane & 15) >> 2)) * VPITCH + ((lane >> 4) & 1) * 32 + (lane & 3) * 8;
    const int nblk = 2 * (Widx / 32) + 1;
    int nb_lo = 0, nb_hi = nblk;
    while (nb_lo < nblk && qpos0 + (-Widx + 32 * nb_lo + 31) * dil < 0) ++nb_lo;
    while (nb_hi > nb_lo && qpos0 + (-Widx + 32 * (nb_hi - 1)) * dil >= T) --nb_hi;
    bf16x8 kf[4], kfn[4]; u32x4 vv[4], vvn[4];
#define BT_LOAD(KF, VV, nbx) do { const int kp0_ = qpos0 + (-Widx + 32 * (nbx)) * dil; int kn_ = kp0_ + r32 * dil; kn_ = kn_ < 0 ? 0 : (kn_ > T - 1 ? T - 1 : kn_); \
        _Pragma("unroll") for (int ks = 0; ks < 4; ++ks) KF[ks] = *(const bf16x8*)(Kp + (size_t)kn_ * NPROJ + ks * 16 + hi * 8); \
        _Pragma("unroll") for (int i = 0; i < 4; ++i) { int vn_ = kp0_ + ((lane >> 3) + 8 * i) * dil; vn_ = vn_ < 0 ? 0 : (vn_ > T - 1 ? T - 1 : vn_); \
            VV[i] = *(const u32x4*)(Vp + (size_t)vn_ * NPROJ + (lane & 7) * 8); } } while (0)
    if (nb_lo < nb_hi) BT_LOAD(kfn, vvn, nb_lo);
    for (int nb = nb_lo; nb < nb_hi; ++nb) {
#pragma unroll
        for (int ks = 0; ks < 4; ++ks) kf[ks] = kfn[ks];
#pragma unroll
        for (int i = 0; i < 4; ++i) vv[i] = vvn[i];
        if (nb + 1 < nb_hi) BT_LOAD(kfn, vvn, nb + 1);
        asm volatile("" ::: "memory");
#pragma unroll
        for (int i = 0; i < 4; ++i) *(LAS u32x4*)(stg + ((lane >> 3) + 8 * i) * VPITCH + (lane & 7) * 16) = vv[i];
        asm volatile("" ::: "memory");
        const int rel = -Widx + 32 * nb, kp0 = qpos0 + rel * dil;
        const bool inr = kp0 >= 0 && kp0 + 31 * dil < T;
        band_block<NH>(kf, qf, rel, Widx, inr, kp0, dil, sl, rho, m, l, mset, o, vbase, scr, lane);
        asm volatile("" ::: "memory");
    }
#undef BT_LOAD
    (void)nq;
}
DI void bcast_rows(LAS float* scr, float v, float (&out)[16], const int lane) {
    const int hi = lane >> 5;
    asm volatile("" ::: "memory"); if (lane < 32) scr[lane] = v; asm volatile("" ::: "memory");
#pragma unroll
    for (int g = 0; g < 4; ++g) { const f32x4 a4 = *(const LAS f32x4*)(scr + 8 * g + 4 * hi);
#pragma unroll
        for (int e = 0; e < 4; ++e) out[4 * g + e] = a4[e]; }
    asm volatile("" ::: "memory");
}
DI void store_o_tile(const f32x16 (&o)[2], bf16* MIXb  , int row0, int rstride, int col0, LAS unsigned char* stg, const int lane) {
    const int r32 = lane & 31, hi = lane >> 5;
    constexpr int OP = 144;
    asm volatile("" ::: "memory");
#pragma unroll
    for (int d0 = 0; d0 < 2; ++d0)
#pragma unroll
        for (int r = 0; r < 16; ++r) *(LAS unsigned short*)(stg + crow(r, hi) * OP + (d0 * 32 + r32) * 2) = (unsigned short)f2bf(o[d0][r]);
    asm volatile("" ::: "memory");
#pragma unroll
    for (int i = 0; i < 4; ++i) { const int row = (lane >> 3) + 8 * i; const u32x4 v = *(const LAS u32x4*)(stg + row * OP + (lane & 7) * 16);
        *(u32x4*)(MIXb + (size_t)(row0 + row * rstride) * D + col0 + (lane & 7) * 8) = v; }
    asm volatile("" ::: "memory");
}

constexpr int AK_OFF = ACC_OFF, AKB = 64 * 128, AV_OFF = AK_OFF + 2 * AKB, AVP = 192, AVB = 64 * AVP;
static_assert(AV_OFF + 2 * AVB <= 131072, "attention A LDS map");
DI void attnA_unit(Frame& F, int layer, int b, int h, int qb, float lam_full, float omli, LAS unsigned char* stg, LAS float* scr) {
    const int lane = F.lane, r32 = lane & 31, hi = lane >> 5, tid = F.tid;
    const bf16* base = F.PROJ + (size_t)b * T * NPROJ;
    const float slope2 = slope_of(6 + h) * LOG2E;
    const int Q0 = qb * 256, qw0 = Q0 + F.wave * 32, q_lane = qw0 + r32;
    bf16x8 qf[2][2];
#pragma unroll
    for (int st = 0; st < 2; ++st)
#pragma unroll
        for (int ks = 0; ks < 2; ++ks) qf[st][ks] = *(const bf16x8*)(base + (size_t)q_lane * NPROJ + QA + h * 64 + st * 32 + ks * 16 + hi * 8);
    float brho[16];
#pragma unroll
    for (int r = 0; r < 16; ++r) brho[r] = slope2 * (float)crow(r, hi);
    float m[2] = {0.f, 0.f}, l[2] = {0.f, 0.f};
    f32x16 o[2][2];
#pragma unroll
    for (int st = 0; st < 2; ++st)
#pragma unroll
        for (int d0 = 0; d0 < 2; ++d0)
#pragma unroll
            for (int r = 0; r < 16; ++r) o[st][d0][r] = 0.f;
    const int srow = tid >> 3, sch = tid & 7;
    const bf16* kg = base + (size_t)srow * NPROJ + KA + h * 64 + sch * 8;
    const bf16* vg = base + (size_t)srow * NPROJ + VA + h * 64 + sch * 8;
    LAS unsigned char* kw = F.lds + AK_OFF + srow * 128 + ((sch ^ (srow & 7)) << 4);
    LAS unsigned char* vw = F.lds + AV_OFF + srow * AVP + sch * 16;
    int koff[2][2];
#pragma unroll
    for (int st = 0; st < 2; ++st)
#pragma unroll
        for (int ks = 0; ks < 2; ++ks) koff[st][ks] = AK_OFF + r32 * 128 + (((st * 4 + ks * 2 + hi) ^ (r32 & 7)) << 4);
    const int voff = AV_OFF + (4 * hi + ((lane & 15) >> 2)) * AVP + ((lane >> 4) & 1) * 32 + (lane & 3) * 8;
    constexpr int NT = T / 64;
    auto tile_of = [&](int i) { return i < 4 ? 4 * qb + i : (i < 4 + 4 * qb ? 4 * qb + 3 - i : i); };
    u32x4 kr, vr;
    { const int t0 = tile_of(0); kr = *(const u32x4*)(kg + (size_t)t0 * 64 * NPROJ); vr = *(const u32x4*)(vg + (size_t)t0 * 64 * NPROJ); }
    __syncthreads();
    *(LAS u32x4*)kw = kr; *(LAS u32x4*)vw = vr;
    __syncthreads();
    bool first = true;
#pragma unroll 1
    for (int i = 0; i < NT; ++i) {
        const int t = tile_of(i), buf = i & 1;
        if (i + 1 < NT) { const int tn = tile_of(i + 1); kr = *(const u32x4*)(kg + (size_t)tn * 64 * NPROJ); vr = *(const u32x4*)(vg + (size_t)tn * 64 * NPROJ); }
#pragma unroll 1
        for (int kb = 0; kb < 2; ++kb) {
            const int kblk0 = t * 64 + kb * 32;
            const int rel = kblk0 - qw0;
            bf16x8 pa[2][2];
#pragma unroll
            for (int st = 0; st < 2; ++st) {
                const bf16x8 kf0 = *(const LAS bf16x8*)(F.lds + koff[st][0] + buf * AKB + kb * 4096);
                const bf16x8 kf1 = *(const LAS bf16x8*)(F.lds + koff[st][1] + buf * AKB + kb * 4096);
                f32x16 acc;
                if (rel != 0) {
                    const float dq = (float)(kblk0 - q_lane), bs = -slope2 * fabsf(dq) - m[st], sg = rel < 0 ? 1.0f : -1.0f;
#pragma unroll
                    for (int r = 0; r < 16; ++r) acc[r] = __builtin_fmaf(sg, brho[r], bs);
                    acc = __builtin_amdgcn_mfma_f32_32x32x16_bf16(kf0, qf[st][0], acc, 0, 0, 0);
                    acc = __builtin_amdgcn_mfma_f32_32x32x16_bf16(kf1, qf[st][1], acc, 0, 0, 0);
                } else {
#pragma unroll
                    for (int r = 0; r < 16; ++r) acc[r] = 0.f;
                    acc = __builtin_amdgcn_mfma_f32_32x32x16_bf16(kf0, qf[st][0], acc, 0, 0, 0);
                    acc = __builtin_amdgcn_mfma_f32_32x32x16_bf16(kf1, qf[st][1], acc, 0, 0, 0);
                    const float qs = slope2 * (float)r32;
#pragma unroll
                    for (int r = 0; r < 16; ++r) acc[r] = acc[r] - fabsf(qs - brho[r]) - m[st];
                }
                float mt = max3f(acc[0], acc[1], acc[2]);
#pragma unroll
                for (int r = 3; r < 15; r += 2) mt = max3f(mt, acc[r], acc[r + 1]);
                mt = fmaxf(mt, acc[15]);
                mt = fmaxf(mt, __shfl_xor(mt, 32));
                if (__any(mt > ATHR) || first) {
                    const float d = first ? mt : fmaxf(mt, 0.f), f = first ? 0.f : __builtin_amdgcn_exp2f(-d);
                    m[st] += d; l[st] *= f;
                    float fr[16]; bcast_rows(scr, f, fr, lane);
#pragma unroll
                    for (int r = 0; r < 16; ++r) { o[st][0][r] *= fr[r]; o[st][1][r] *= fr[r]; acc[r] -= d; }
                }
                float ls = 0.f;
#pragma unroll
                for (int r = 0; r < 16; ++r) { acc[r] = __builtin_amdgcn_exp2f(acc[r]); ls += acc[r]; }
                l[st] += ls;
#pragma unroll
                for (int s = 0; s < 2; ++s) { u32x4 pw; pw.x = cvtpk(acc[8 * s], acc[8 * s + 1]); pw.y = cvtpk(acc[8 * s + 2], acc[8 * s + 3]); pw.z = cvtpk(acc[8 * s + 4], acc[8 * s + 5]); pw.w = cvtpk(acc[8 * s + 6], acc[8 * s + 7]);
                    pa[st][s] = __builtin_bit_cast(bf16x8, pw); }
            }
            first = false;
#pragma unroll
            for (int s = 0; s < 2; ++s)
#pragma unroll
                for (int d0 = 0; d0 < 2; ++d0) {
                    const LAS unsigned char* vp = F.lds + voff + buf * AVB + (kb * 32 + s * 16) * AVP + d0 * 64;
                    const v4i16_t lo = __builtin_amdgcn_ds_read_tr16_b64_v4i16((LAS v4i16_t*)vp);
                    const v4i16_t hh = __builtin_amdgcn_ds_read_tr16_b64_v4i16((LAS v4i16_t*)(vp + 8 * AVP));
                    const bf16x8 vf = __builtin_shufflevector(lo, hh, 0, 1, 2, 3, 4, 5, 6, 7);
                    o[0][d0] = __builtin_amdgcn_mfma_f32_32x32x16_bf16(pa[0][s], vf, o[0][d0], 0, 0, 0);
                    o[1][d0] = __builtin_amdgcn_mfma_f32_32x32x16_bf16(pa[1][s], vf, o[1][d0], 0, 0, 0);
                }
        }
        if (i + 1 < NT) { *(LAS u32x4*)(kw + (buf ^ 1) * AKB) = kr; *(LAS u32x4*)(vw + (buf ^ 1) * AVB) = vr; }
        __syncthreads();
    }
    float l0 = l[0] + __shfl_xor(l[0], 32), l1 = l[1] + __shfl_xor(l[1], 32);
    float f0[16], f1[16];
    bcast_rows(scr, 1.0f / l0, f0, lane); bcast_rows(scr, lam_full / l1, f1, lane);
    const float g0 = F.subln_g[layer * 64 + r32] * omli, g1 = F.subln_g[layer * 64 + 32 + r32] * omli;
#pragma unroll
    for (int r = 0; r < 16; ++r) {
        const float a = o[0][0][r] * f0[r] - o[1][0][r] * f1[r], c = o[0][1][r] * f0[r] - o[1][1][r] * f1[r];
        float ss = a * a + c * c;
        ss += __shfl_xor(ss, 1); ss += __shfl_xor(ss, 2); ss += __shfl_xor(ss, 4); ss += __shfl_xor(ss, 8); ss += __shfl_xor(ss, 16);
        const float rs = 1.0f / sqrtf(ss * (1.0f / 64.0f) + LN_EPS);
        o[0][0][r] = a * rs * g0; o[0][1][r] = c * rs * g1;
    }
    store_o_tile(o[0], F.MIX + (size_t)b * T * D, qw0, 1, OA + h * 64, stg, lane);
}
DI void attnC_unit(Frame& F, int layer, int b, int hq, int qb, LAS unsigned char* stg, LAS float* scr) {
    const int kvh = hq / 3;
    const int lane = F.lane, r32 = lane & 31, hi = lane >> 5, tid = F.tid;
    const bf16* base = F.PROJ + (size_t)b * T * NPROJ;
    const int Q0 = qb * 256, qw0 = Q0 + F.wave * 32, q_lane = qw0 + r32;
    bf16x8 qf[1][4];
#pragma unroll
    for (int hd = 0; hd < 1; ++hd)
#pragma unroll
        for (int ks = 0; ks < 4; ++ks) qf[hd][ks] = *(const bf16x8*)(base + (size_t)q_lane * NPROJ + QC + (hq + hd) * 64 + ks * 16 + hi * 8);
    float rho[16], sl[1], m[1], l[1]; bool mset[1]; f32x16 o[1][2];
#pragma unroll
    for (int r = 0; r < 16; ++r) rho[r] = (float)crow(r, hi);
#pragma unroll
    for (int hd = 0; hd < 1; ++hd) { sl[hd] = slope_of(hq + hd) * LOG2E; m[hd] = 0.f; l[hd] = 0.f; mset[hd] = false;
#pragma unroll
        for (int r = 0; r < 16; ++r) { o[hd][0][r] = 0.f; o[hd][1][r] = 0.f; } }
    const int srow = tid >> 3, sch = tid & 7;
    const bf16* kg = base + (size_t)srow * NPROJ + KC + kvh * 64 + sch * 8;
    const bf16* vg = base + (size_t)srow * NPROJ + VC + kvh * 64 + sch * 8;
    LAS unsigned char* kw = F.lds + AK_OFF + srow * 128 + ((sch ^ (srow & 7)) << 4);
    LAS unsigned char* vw = F.lds + AV_OFF + srow * AVP + sch * 16;
    int koff[4];
#pragma unroll
    for (int ks = 0; ks < 4; ++ks) koff[ks] = AK_OFF + r32 * 128 + (((ks * 2 + hi) ^ (r32 & 7)) << 4);
    const int voff = AV_OFF + (4 * hi + ((lane & 15) >> 2)) * AVP + ((lane >> 4) & 1) * 32 + (lane & 3) * 8;
    const int t_lo = 4 * qb - 2 < 0 ? 0 : 4 * qb - 2, t_hi = 4 * qb + 6 > T / 64 ? T / 64 : 4 * qb + 6, ntc = t_hi - t_lo;
    u32x4 kr, vr;
    kr = *(const u32x4*)(kg + (size_t)t_lo * 64 * NPROJ); vr = *(const u32x4*)(vg + (size_t)t_lo * 64 * NPROJ);
    __syncthreads();
    *(LAS u32x4*)kw = kr; *(LAS u32x4*)vw = vr;
    __syncthreads();
#pragma unroll 1
    for (int i = 0; i < ntc; ++i) {
        const int t = t_lo + i, buf = i & 1;
        if (i + 1 < ntc) { kr = *(const u32x4*)(kg + (size_t)(t + 1) * 64 * NPROJ); vr = *(const u32x4*)(vg + (size_t)(t + 1) * 64 * NPROJ); }
#pragma unroll 1
        for (int kb = 0; kb < 2; ++kb) {
            const int rel = t * 64 + kb * 32 - qw0;
            if (rel < -128 || rel > 128) continue;
            bf16x8 kf[4];
#pragma unroll
            for (int ks = 0; ks < 4; ++ks) kf[ks] = *(const LAS bf16x8*)(F.lds + koff[ks] + buf * AKB + kb * 4096);
            band_block<1>(kf, qf, rel, 128, true, 0, 1, sl, rho, m, l, mset, o, F.lds + voff + buf * AVB + kb * 32 * AVP, scr, lane);
        }
        if (i + 1 < ntc) { *(LAS u32x4*)(kw + (buf ^ 1) * AKB) = kr; *(LAS u32x4*)(vw + (buf ^ 1) * AVB) = vr; }
        __syncthreads();
    }
#pragma unroll
    for (int hd = 0; hd < 1; ++hd) {
        const float lt = l[hd] + __shfl_xor(l[hd], 32);
        const float sk2 = F.sink[layer * 6 + hq + hd] * LOG2E, mx = fmaxf(m[hd], sk2), a = __builtin_amdgcn_exp2f(m[hd] - mx);
        const float f = a / (lt * a + __builtin_amdgcn_exp2f(sk2 - mx));
        float fr[16]; bcast_rows(scr, f, fr, lane);
#pragma unroll
        for (int r = 0; r < 16; ++r) { o[hd][0][r] *= fr[r]; o[hd][1][r] *= fr[r]; }
        store_o_tile(o[hd], F.MIX + (size_t)b * T * D, qw0, 1, OC + (hq + hd) * 64, stg, lane);
    }
}
template <int PS>
DI void attnB_pass(Frame& F, const bf16* Qp, const bf16* Kp, const bf16* Vp, bf16* MIXb, int colo, int p0, float slope2, float scale2, LAS unsigned char* stg, LAS float* scr) {
    constexpr int dil = PS == 0 ? 16 : (PS == 1 ? 4 : 1), ntask = PS == 0 ? 16 : 8, nq = PS == 0 ? 16 : 32;
    LAS float* accO = (LAS float*)(F.lds + ACC_OFF); LAS float* accM = accO + 256 * 64; LAS float* accL = accM + 256;
    const int lane = F.lane, r32 = lane & 31, hi = lane >> 5;
#pragma unroll 1
    for (int t = F.wave; t < ntask; t += NWAVES) {
        int qfirst;
        if (PS == 0) qfirst = p0 + t; else if (PS == 1) qfirst = p0 + (t & 3) + 128 * (t >> 2); else qfirst = p0 + 32 * t;
        f32x16 o1[1][2]; float m1[1], l1[1]; const float sl1[1] = {slope2 * (float)dil};
        band_task2<1>(Qp, Kp, Vp, qfirst, dil, 64, nq, sl1, stg, scr, m1, l1, o1, F.lane);
        f32x16 (&o)[2] = o1[0]; const float m = m1[0]; float l = l1[0];
        l += __shfl_xor(l, 32);
        const int rowloc0 = qfirst - p0;
        const int qloc = rowloc0 + r32 * dil;
        float fo = 0.f, ft = 1.f, mn = m, ln = l;
        if (PS > 0) { const float mo = accM[qloc], lo = accL[qloc]; mn = fmaxf(mo, m); fo = __builtin_amdgcn_exp2f(mo - mn); ft = __builtin_amdgcn_exp2f(m - mn); ln = lo * fo + l * ft; }
        if (PS == 2) { const float inv = 1.0f / ln; fo *= inv; ft *= inv; }
        else if (lane < nq) { accM[qloc] = mn; accL[qloc] = ln; }
        if (PS == 0) {
#pragma unroll
            for (int r = 0; r < 8; ++r) { LAS float* ap = accO + (rowloc0 + crow(r, hi) * dil) * 64 + r32; ap[0] = o[0][r]; ap[32] = o[1][r]; }
        } else {
            float fo_r[16], ft_r[16];
            bcast_rows(scr, fo, fo_r, F.lane); bcast_rows(scr, ft, ft_r, F.lane);
#pragma unroll
            for (int r = 0; r < 16; ++r) { LAS float* ap = accO + (rowloc0 + crow(r, hi) * dil) * 64 + r32;
                const float a0 = ap[0] * fo_r[r] + o[0][r] * ft_r[r], a1 = ap[32] * fo_r[r] + o[1][r] * ft_r[r];
                if (PS == 1) { ap[0] = a0; ap[32] = a1; } else { o[0][r] = a0; o[1][r] = a1; } }
            if (PS == 2) store_o_tile(o, MIXb, qfirst, 1, colo, stg, F.lane);
        }
    }
}
DI void attnB_unit(Frame& F, int b, int hb, int p0, LAS unsigned char* stg, LAS float* scr) {
    const bf16* base = F.PROJ + (size_t)b * T * NPROJ;
    const bf16 *Qp = base + QB + hb * 64, *Kp = base + KB + hb * 64, *Vp = base + VB + hb * 64;
    bf16* MIXb = F.MIX + (size_t)b * T * D;
    const float slope2 = slope_of(10 + hb) * LOG2E, scale2 = 1.0f;
    __syncthreads();
    attnB_pass<0>(F, Qp, Kp, Vp, MIXb, OB + hb * 64, p0, slope2, scale2, stg, scr);
    __syncthreads();
    attnB_pass<1>(F, Qp, Kp, Vp, MIXb, OB + hb * 64, p0, slope2, scale2, stg, scr);
    __syncthreads();
    attnB_pass<2>(F, Qp, Kp, Vp, MIXb, OB + hb * 64, p0, slope2, scale2, stg, scr);
}
DI void attn_phase(Frame& F, int layer) {
    LAS unsigned char* stg = F.lds + F.wave * WAVE_LDS; LAS float* scr = (LAS float*)(stg + STG_BYTES);
    const float* lam = F.lam + layer * 128;
    float d1 = F.lane < 32 ? lam[F.lane] * lam[32 + F.lane] : 0.f, d2 = F.lane < 32 ? lam[64 + F.lane] * lam[96 + F.lane] : 0.f;
    d1 = wave_sum(d1); d2 = wave_sum(d2);
    const float lambda_init = 0.8f - 0.6f * __expf(-0.3f * (float)layer);
    const float lam_full = __expf(d1) - __expf(d2) + lambda_init, omli = 1.0f - lambda_init;
    constexpr int NU_A = BATCH * 4 * (T / 256), NU_C = BATCH * 6 * (T / 256), NU_B = BATCH * 6 * (T / 256);
    for (int u = blockIdx.x; u < NU_A + NU_C + NU_B; u += F.G) {
        { int t_ = threadIdx.x; asm volatile("" : "+v"(t_)); F.tid = t_; F.lane = t_ & 63; }
#ifndef ATTSEL
#define ATTSEL 7
#endif
        if (u < NU_A) { if (ATTSEL & 1) { const int b = u / 64, h = (u / 16) & 3, qb = u & 15; for (int rep = 0; rep < REP_A; ++rep) attnA_unit(F, layer, b, h, qb, lam_full, omli, stg, scr); } }
        else if (u < NU_A + NU_C) { if (ATTSEL & 2) { const int uc = u - NU_A, b = uc / 96, hq = (uc / 16) % 6, qb = uc & 15;
            for (int rep = 0; rep < REP_C; ++rep) attnC_unit(F, layer, b, hq, qb, stg, scr); } }
        else if (ATTSEL & 4) { const int ub = u - NU_A - NU_C, b = ub / 96, hb = (ub / 16) % 6, pb = ub & 15; for (int rep = 0; rep < REP_B; ++rep) attnB_unit(F, b, hb, pb * 256, stg, scr); }
    }
}
#ifndef REP_G1
#define REP_G1 1
#endif
#ifndef REP_G3
#define REP_G3 1
#endif

struct Args { const float* in[13]; float* out; unsigned char* ws; int ph_lo, ph_hi; };
__global__ void __launch_bounds__(NWAVES * 64, 2) fwd(Args args) {
    extern __shared__ __attribute__((aligned(16))) unsigned char lds[];
    Frame F;
    F.lds = (LAS unsigned char*)lds;
    F.tid = threadIdx.x; F.lane = F.tid & 63; F.wave = __builtin_amdgcn_readfirstlane(F.tid >> 6); F.G = gridDim.x;
    F.x = args.in[0]; F.c = args.in[1]; F.w_ada = args.in[2]; F.b_ada = args.in[3]; F.w_in = args.in[4]; F.lam = args.in[5]; F.subln_g = args.in[6];
    F.sink = args.in[7]; F.w_out = args.in[8]; F.ln_g = args.in[9]; F.ln_b = args.in[10]; F.w_gu = args.in[11]; F.w_down = args.in[12];
    F.out = args.out; F.ws = args.ws;
    F.mod = (float*)(args.ws + WS_MOD); F.H = (bf16*)(args.ws + WS_H); F.PROJ = (bf16*)(args.ws + WS_PROJ); F.MIX = (bf16*)(args.ws + WS_MIX); F.ACT = (bf16*)(args.ws + WS_ACT);
    cg::grid_group grid = cg::this_grid();
    volatile LAS unsigned* MISC = (volatile LAS unsigned*)(F.lds + LDS_BYTES - 256);
    if (F.tid < 64) MISC[F.tid] = 0u;
    __syncthreads();
    const XcdBarrier bar = xcd_barrier_post((unsigned*)(args.ws + WS_CTL), MISC + 8);
    const int lo = args.ph_lo, hi = args.ph_hi;
    const float alpha = 1.4142135623730951f;
#ifndef PHMASK
#define PHMASK 0x1ff
#endif
#define IN(k) (lo <= (k) && (k) < hi)
#define INM(bit, k) (((PHMASK >> (bit)) & 1) && IN(k))
#define RELANE() do { int t_ = threadIdx.x; asm volatile("" : "+v"(t_)); F.tid = t_; F.lane = t_ & 63; } while (0)
#define SEAM(k) do { if (IN(k) && IN((k) + 1)) { if ((k) == 0) grid.sync(); else xcd_barrier(bar); } } while (0)
    if (INM(0, 0)) { RELANE(); p0_phase(F); } SEAM(0);
    if (INM(1, 1)) { RELANE(); row_mod_phase(F, F.x, F.mod + 1 * D, F.mod + 0 * D, F.H); } SEAM(1);
#pragma unroll 1
    for (int layer = 0; layer < DEPTH; ++layer) {
        const int pb = 2 + 7 * layer;
        const float* modl = F.mod + (size_t)layer * BATCH * NMOD;
        if (INM(2, pb + 0)) {
            pg8::Gemm g{F.H, wptr(F, layer, WO_IN), M, NPROJ, D}; pg8::StaticOrder S; S.init(M, NPROJ, F.G, (int)blockIdx.x);
            pg8::EpiProj E{F.PROJ, NPROJ};
            for (int rep = 0; rep < REP_G1; ++rep) pg8::gemm_phase<pg8::EpiProj, pg8::StaticOrder, true, true>(F.lds, g, S, E);
        } SEAM(pb + 0);
        if (INM(3, pb + 1)) { RELANE(); attn_phase(F, layer); } SEAM(pb + 1);
        if (INM(4, pb + 2)) {
            pg8::Gemm g{F.MIX, wptr(F, layer, WO_OUT), M, D, D}; pg8::StaticOrder S; S.init(M, D, F.G, (int)blockIdx.x);
            pg8::EpiResid E{layer == 0 ? F.x : F.out, F.out, modl + 2 * D, alpha};
            pg8::gemm_phase<pg8::EpiResid, pg8::StaticOrder, true, true>(F.lds, g, S, E);
        } SEAM(pb + 2);
        if (INM(5, pb + 3)) { RELANE(); row_ln_phase(F, F.out, F.ln_g + (size_t)(layer * 2 + 0) * D, F.ln_b + (size_t)(layer * 2 + 0) * D, modl + 4 * D, modl + 3 * D, F.H); } SEAM(pb + 3);
        if (INM(6, pb + 4)) {
            pg8::Gemm g{F.H, wptr(F, layer, WO_GU), M, NGU, D}; pg8::StaticOrder S; S.init(M, NGU, F.G, (int)blockIdx.x);
            pg8::EpiSwiGLU E{F.ACT, FF};
            for (int rep = 0; rep < REP_G3; ++rep) pg8::gemm_phase<pg8::EpiSwiGLU, pg8::StaticOrder, true, true>(F.lds, g, S, E);
        } SEAM(pb + 4);
        if (INM(7, pb + 5)) {
            pg8::Gemm g{F.ACT, wptr(F, layer, WO_DN), M, D, FF}; pg8::StaticOrder S; S.init(M, D, F.G, (int)blockIdx.x);
            pg8::EpiResid E{F.out, F.out, modl + 5 * D, alpha};
            pg8::gemm_phase<pg8::EpiResid, pg8::StaticOrder, true, true>(F.lds, g, S, E);
        } SEAM(pb + 5);
        if (INM(8, pb + 6)) { const bool last = layer == DEPTH - 1; const float* modn = modl + (size_t)BATCH * NMOD;
            RELANE(); row_ln_phase(F, F.out, F.ln_g + (size_t)(layer * 2 + 1) * D, F.ln_b + (size_t)(layer * 2 + 1) * D, modn + 1 * D, modn + 0 * D, last ? (bf16*)nullptr : F.H); }
        SEAM(pb + 6);
    }
#undef IN
#undef SEAM
}

#ifndef MK_FUSED
#define MK_FUSED 0
#endif
extern "C" void kernel_launch(void* const* d_in, const int* in_sizes, int n_in, void* d_out, int out_size, void* d_ws, size_t ws_size, hipStream_t stream) {
    static int grid = 0;
    if (grid == 0) {
        if (n_in != 13 || in_sizes[0] != M * D || out_size != M * D || ws_size < WS_END) { fprintf(stderr, "kernel_launch: unexpected shapes (n_in %d, in0 %d, out %d, ws %zu)\n", n_in, n_in > 0 ? in_sizes[0] : -1, out_size, ws_size); grid = -1; return; }
        int dev = 0, cus = 0, per_cu = 0;
        if (hipGetDevice(&dev) != hipSuccess || hipDeviceGetAttribute(&cus, hipDeviceAttributeMultiprocessorCount, dev) != hipSuccess) { grid = -1; return; }
        if (hipFuncSetAttribute((const void*)fwd, hipFuncAttributeMaxDynamicSharedMemorySize, LDS_BYTES) != hipSuccess) { fprintf(stderr, "kernel_launch: hipFuncSetAttribute failed\n"); grid = -1; return; }
        if (hipOccupancyMaxActiveBlocksPerMultiprocessor(&per_cu, (const void*)fwd, NWAVES * 64, LDS_BYTES) != hipSuccess || per_cu < 1) { fprintf(stderr, "kernel_launch: occupancy query says %d blocks per CU\n", per_cu); per_cu = 1; }
        (void)hipGetLastError();
        grid = cus;
    }
    if (grid < 0) return;
    if (hipMemsetAsync((char*)d_ws + WS_CTL, 0, 16384, stream) != hipSuccess) { fprintf(stderr, "kernel_launch: memset failed\n"); return; }
    Args a{};
    for (int i = 0; i < 13; ++i) a.in[i] = (const float*)d_in[i];
    a.out = (float*)d_out; a.ws = (unsigned char*)d_ws;
#if MK_FUSED
    a.ph_lo = 0; a.ph_hi = N_PHASES;
    void* kargs[] = {&a};
    hipError_t e = hipLaunchCooperativeKernel((const void*)fwd, dim3(grid), dim3(NWAVES * 64), kargs, LDS_BYTES, stream);
    if (e != hipSuccess) fprintf(stderr, "kernel_launch: cooperative launch failed: %s (grid %d)\n", hipGetErrorString(e), grid);
#else
    for (int p = 0; p < N_PHASES; ++p) { a.ph_lo = p; a.ph_hi = p + 1; hipLaunchKernelGGL(fwd, dim3(grid), dim3(NWAVES * 64), LDS_BYTES, stream, a); }
#endif
}
```
